# Optimizing an MI355X kernel written in HIP

```python
import math
import jax, jax.numpy as jnp
from jax import lax
import numpy as np

D_MODEL = 2048
BATCH = 1
SEQ = 8192
DEPTH = 1

ATTN_HEADS = 16
HEAD_DIM = 64
ATTN_WIDTH = ATTN_HEADS * HEAD_DIM
SSM_GROUP = 16
SSM_GROUPS = (D_MODEL - ATTN_WIDTH) // SSM_GROUP
SSM_WIDTH = SSM_GROUPS * SSM_GROUP
MIX_WIDTH = ATTN_WIDTH + SSM_WIDTH
IN_WIDTH = 3 * ATTN_WIDTH + SSM_WIDTH
SSM_STATE = 64
DILATED_PATTERNS = ((128, 1), (512, 4), (2048, 16))
ATTN_BLOCK = 128
ROPE_THETA = 10000.0
NEG_INF = -1e30
PEER_HEADS = 8
PEER_KEY_DIM = 256
PEER_SUB_DIM = PEER_KEY_DIM // 2
PEER_N_KEYS = 128
PEER_N_EXPERTS = PEER_N_KEYS * PEER_N_KEYS
PEER_TOPK = 16
PEER_CHUNK = 128
LN_EPS = 1e-5
DEEPNORM_ALPHA = (2.0 * DEPTH) ** 0.25
DEEPNORM_BETA = (8.0 * DEPTH) ** -0.25
ADA_SCALE = 0.3

kernel_name = "hymba_dilated_s5_peer_deepnorm_block"


def _layernorm(x, g=None, b=None):
    xf = x.astype(jnp.float32)
    mu = jnp.mean(xf, axis=-1, keepdims=True)
    var = jnp.mean(jnp.square(xf - mu), axis=-1, keepdims=True)
    y = (xf - mu) * lax.rsqrt(var + LN_EPS)
    if g is not None:
        y = y * g.astype(jnp.float32) + b.astype(jnp.float32)
    return y.astype(x.dtype)


def _rmsnorm(x, g):
    xf = x.astype(jnp.float32)
    y = xf * lax.rsqrt(jnp.mean(jnp.square(xf), axis=-1, keepdims=True) + LN_EPS)
    return (y * g.astype(jnp.float32)).astype(x.dtype)


def _rope(x, positions):
    half = HEAD_DIM // 2
    inv_freq = ROPE_THETA ** (-jnp.arange(half, dtype=jnp.float32) / half)
    ang = positions.astype(jnp.float32)[..., None] * inv_freq
    cos = jnp.cos(ang)[:, :, None, :]
    sin = jnp.sin(ang)[:, :, None, :]
    xf = x.astype(jnp.float32)
    x1, x2 = xf[..., :half], xf[..., half:]
    return jnp.concatenate([x1 * cos - x2 * sin, x2 * cos + x1 * sin], axis=-1).astype(x.dtype)


def _dilated_window_attention(q, k, v, window, dilation):
    B, S, H, E = q.shape
    L = S // dilation
    W = window // dilation
    nb = -(-L // ATTN_BLOCK)
    Lp = nb * ATTN_BLOCK

    def to_blocks(t):
        t = t.reshape(B, L, dilation, H, E).transpose(0, 2, 1, 3, 4)
        t = jnp.pad(t, ((0, 0), (0, 0), (0, Lp - L), (0, 0), (0, 0)))
        return t.reshape(B, dilation, nb, ATTN_BLOCK, H, E)

    def with_prev(t):
        prev = jnp.pad(t, ((0, 0), (0, 0), (1, 0), (0, 0), (0, 0), (0, 0)))[:, :, :-1]
        return jnp.concatenate([prev, t], axis=3)

    qb, kb, vb = to_blocks(q), to_blocks(k), to_blocks(v)
    kw, vw = with_prev(kb), with_prev(vb)
    s = jnp.einsum('bdnqhe,bdnkhe->bdnhqk', qb, kw,
                   preferred_element_type=jnp.float32) * (E ** -0.5)
    qi = jnp.arange(ATTN_BLOCK)[:, None] + ATTN_BLOCK
    kj = jnp.arange(2 * ATTN_BLOCK)[None, :]
    rel = qi - kj
    band = (rel >= 0) & (rel <= W)
    has_prev = (jnp.arange(nb)[:, None, None] > 0) | (kj >= ATTN_BLOCK)[None]
    mask = band[None] & has_prev
    s = jnp.where(mask[None, None, :, None], s, NEG_INF)
    m = jnp.max(s, axis=-1, keepdims=True)
    p = jnp.exp(s - m)
    l = jnp.sum(p, axis=-1, keepdims=True)
    o = jnp.einsum('bdnhqk,bdnkhe->bdnqhe', p / l, vw.astype(jnp.float32))
    lse = (m + jnp.log(l))[..., 0]
    o = o.reshape(B, dilation, Lp, H, E)[:, :, :L].transpose(0, 2, 1, 3, 4).reshape(B, S, H, E)
    lse = lse.transpose(0, 1, 2, 4, 3).reshape(B, dilation, Lp, H)[:, :, :L]
    lse = lse.transpose(0, 2, 1, 3).reshape(B, S, H)
    return o, lse


def _complex_affine_combine(e1, e2):
    a1r, a1i, b1r, b1i = e1
    a2r, a2i, b2r, b2i = e2
    ar = a2r * a1r - a2i * a1i
    ai = a2r * a1i + a2i * a1r
    br = a2r * b1r - a2i * b1i + b2r
    bi = a2r * b1i + a2i * b1r + b2i
    return (ar, ai, br, bi)


def _s5(u, lam_re, lam_im, log_dt, b_re, b_im, c_re, c_im, d_skip):
    uf = u.astype(jnp.float32)
    dt = jnp.exp(log_dt.astype(jnp.float32))[:, None]
    lr = lam_re.astype(jnp.float32)
    li = lam_im.astype(jnp.float32)
    mag = jnp.exp(lr * dt)
    ar = mag * jnp.cos(li * dt)
    ai = mag * jnp.sin(li * dt)
    den = lr * lr + li * li
    cr = ((ar - 1.0) * lr + ai * li) / den
    ci = (ai * lr - (ar - 1.0) * li) / den
    br = b_re.astype(jnp.float32)
    bi = b_im.astype(jnp.float32)
    bbar_re = cr[..., None] * br - ci[..., None] * bi
    bbar_im = cr[..., None] * bi + ci[..., None] * br
    bu_re = jnp.einsum('bsgp,gnp->bsgn', uf, bbar_re)
    bu_im = jnp.einsum('bsgp,gnp->bsgn', uf, bbar_im)
    a_re = jnp.broadcast_to(ar, bu_re.shape)
    a_im = jnp.broadcast_to(ai, bu_im.shape)
    _, _, h_re, h_im = lax.associative_scan(_complex_affine_combine,
                                            (a_re, a_im, bu_re, bu_im), axis=1)
    y = (jnp.einsum('bsgn,gpn->bsgp', h_re, c_re.astype(jnp.float32))
         - jnp.einsum('bsgn,gpn->bsgp', h_im, c_im.astype(jnp.float32))
         + d_skip.astype(jnp.float32) * uf)
    return y


def _peer(h, w_qp, sub_keys, expert_u, expert_v):
    B, S, D = h.shape
    T = B * S
    t = h.reshape(T, D)
    q = (t @ w_qp).reshape(T, PEER_HEADS, 2, PEER_SUB_DIM)
    s = jnp.einsum('thic,ikc->thik', q, sub_keys,
                   preferred_element_type=jnp.float32)
    top_s, top_i = lax.top_k(s, PEER_TOPK)
    cand = top_s[:, :, 0, :, None] + top_s[:, :, 1, None, :]
    best_s, best = lax.top_k(cand.reshape(T, PEER_HEADS, PEER_TOPK * PEER_TOPK), PEER_TOPK)
    i0 = jnp.take_along_axis(top_i[:, :, 0], best // PEER_TOPK, axis=-1)
    i1 = jnp.take_along_axis(top_i[:, :, 1], best % PEER_TOPK, axis=-1)
    experts = i0 * PEER_N_KEYS + i1
    gates = jax.nn.softmax(best_s, axis=-1)
    nc = T // PEER_CHUNK

    def chunk(args):
        tc, ec, gc = args
        u = expert_u[ec]
        v = expert_v[ec]
        act = jax.nn.gelu(jnp.einsum('td,thkd->thk', tc, u,
                                     preferred_element_type=jnp.float32), approximate=False)
        return jnp.einsum('thk,thkd->td', gc * act, v.astype(jnp.float32))

    y = lax.map(chunk, (t.reshape(nc, PEER_CHUNK, D),
                        experts.reshape(nc, PEER_CHUNK, PEER_HEADS, PEER_TOPK),
                        gates.reshape(nc, PEER_CHUNK, PEER_HEADS, PEER_TOPK)))
    return y.reshape(B, S, D).astype(h.dtype)


def setup_inputs(seed: int = 0) -> dict:
    key = jax.random.key(seed)
    ks = jax.random.split(key, 32)
    f32 = jnp.float32
    nrm = lambda k, shape, scale: jax.random.normal(k, shape, f32) * scale
    L, D = DEPTH, D_MODEL
    x = nrm(ks[0], (BATCH, SEQ, D), 1.0)
    c = nrm(ks[1], (BATCH, D), 1.0)
    positions = jnp.broadcast_to(jnp.arange(SEQ, dtype=jnp.int32), (BATCH, SEQ))
    w_ada = nrm(ks[2], (L, D, 6 * D), ADA_SCALE * D ** -0.5)
    b_ada = nrm(ks[3], (L, 6 * D), 0.02)
    col_scale = jnp.concatenate([jnp.ones((2 * ATTN_WIDTH,), f32),
                                 jnp.full((ATTN_WIDTH,), DEEPNORM_BETA, f32),
                                 jnp.ones((SSM_WIDTH,), f32)])
    w_in = nrm(ks[4], (L, D, IN_WIDTH), D ** -0.5) * col_scale
    lam_re = -0.5 + nrm(ks[5], (L, SSM_GROUPS, SSM_STATE), 0.01)
    lam_im = math.pi * jnp.arange(SSM_STATE, dtype=f32) + nrm(ks[6], (L, SSM_GROUPS, SSM_STATE), 0.01)
    log_dt = jax.random.uniform(ks[7], (L, SSM_GROUPS), f32, math.log(1e-3), math.log(1e-1))
    ssm_b_re = nrm(ks[8], (L, SSM_GROUPS, SSM_STATE, SSM_GROUP), (2 * SSM_GROUP) ** -0.5)
    ssm_b_im = nrm(ks[9], (L, SSM_GROUPS, SSM_STATE, SSM_GROUP), (2 * SSM_GROUP) ** -0.5)
    ssm_c_re = nrm(ks[10], (L, SSM_GROUPS, SSM_GROUP, SSM_STATE), (2 * SSM_STATE) ** -0.5)
    ssm_c_im = nrm(ks[11], (L, SSM_GROUPS, SSM_GROUP, SSM_STATE), (2 * SSM_STATE) ** -0.5)
    ssm_d = nrm(ks[12], (L, SSM_GROUPS, SSM_GROUP), 1.0)
    w_glu = nrm(ks[13], (L, SSM_WIDTH, SSM_WIDTH), SSM_WIDTH ** -0.5)
    b_glu = nrm(ks[14], (L, SSM_WIDTH), 0.02)
    g_attn = 1.0 + nrm(ks[15], (L, ATTN_WIDTH), 0.02)
    g_ssm = 1.0 + nrm(ks[16], (L, SSM_WIDTH), 0.02)
    w_out = nrm(ks[17], (L, MIX_WIDTH, D), DEEPNORM_BETA * MIX_WIDTH ** -0.5)
    ln1_g = 1.0 + nrm(ks[18], (L, D), 0.02)
    ln1_b = nrm(ks[19], (L, D), 0.02)
    w_qp = nrm(ks[20], (L, D, PEER_HEADS * PEER_KEY_DIM), D ** -0.5)
    sub_keys = nrm(ks[21], (L, 2, PEER_N_KEYS, PEER_SUB_DIM), PEER_SUB_DIM ** -0.5)
    expert_u = nrm(ks[22], (L, PEER_N_EXPERTS, D), D ** -0.5)
    expert_v = nrm(ks[23], (L, PEER_N_EXPERTS, D), DEEPNORM_BETA)
    ln2_g = 1.0 + nrm(ks[24], (L, D), 0.02)
    ln2_b = nrm(ks[25], (L, D), 0.02)
    return {"x": x, "c": c, "positions": positions, "w_ada": w_ada, "b_ada": b_ada,
            "w_in": w_in, "lam_re": lam_re, "lam_im": lam_im, "log_dt": log_dt,
            "ssm_b_re": ssm_b_re, "ssm_b_im": ssm_b_im, "ssm_c_re": ssm_c_re,
            "ssm_c_im": ssm_c_im, "ssm_d": ssm_d, "w_glu": w_glu, "b_glu": b_glu,
            "g_attn": g_attn, "g_ssm": g_ssm, "w_out": w_out, "ln1_g": ln1_g,
            "ln1_b": ln1_b, "w_qp": w_qp, "sub_keys": sub_keys, "expert_u": expert_u,
            "expert_v": expert_v, "ln2_g": ln2_g, "ln2_b": ln2_b}


def reference(x, c, positions, w_ada, b_ada, w_in, lam_re, lam_im, log_dt,
              ssm_b_re, ssm_b_im, ssm_c_re, ssm_c_im, ssm_d, w_glu, b_glu,
              g_attn, g_ssm, w_out, ln1_g, ln1_b, w_qp, sub_keys, expert_u,
              expert_v, ln2_g, ln2_b):
    B, S, D = x.shape
    for l in range(DEPTH):
        mod = jax.nn.silu(c) @ w_ada[l] + b_ada[l]
        sh1, sc1, gt1, sh2, sc2, gt2 = [m[:, None, :] for m in jnp.split(mod, 6, axis=-1)]

        h = _layernorm(x) * (1.0 + sc1) + sh1
        z = h @ w_in[l]
        q, k, v, u = jnp.split(z, [ATTN_WIDTH, 2 * ATTN_WIDTH, 3 * ATTN_WIDTH], axis=-1)
        q = _rope(q.reshape(B, S, ATTN_HEADS, HEAD_DIM), positions)
        k = _rope(k.reshape(B, S, ATTN_HEADS, HEAD_DIM), positions)
        v = v.reshape(B, S, ATTN_HEADS, HEAD_DIM)
        outs, lses = [], []
        for window, dilation in DILATED_PATTERNS:
            o_p, lse_p = _dilated_window_attention(q, k, v, window, dilation)
            outs.append(o_p)
            lses.append(lse_p)
        wts = jax.nn.softmax(jnp.stack(lses, axis=0), axis=0)
        attn = jnp.sum(wts[..., None] * jnp.stack(outs, axis=0), axis=0)
        attn = attn.reshape(B, S, ATTN_WIDTH).astype(x.dtype)

        y = _s5(u.reshape(B, S, SSM_GROUPS, SSM_GROUP), lam_re[l], lam_im[l], log_dt[l],
                ssm_b_re[l], ssm_b_im[l], ssm_c_re[l], ssm_c_im[l], ssm_d[l])
        y = jax.nn.gelu(y.reshape(B, S, SSM_WIDTH), approximate=False)
        y = (y * jax.nn.sigmoid(y @ w_glu[l] + b_glu[l])).astype(x.dtype)

        mixed = jnp.concatenate([_rmsnorm(attn, g_attn[l]), _rmsnorm(y, g_ssm[l])], axis=-1)
        mix_out = mixed @ w_out[l]
        x = _layernorm(DEEPNORM_ALPHA * x + (1.0 + gt1) * mix_out, ln1_g[l], ln1_b[l])

        h2 = _layernorm(x) * (1.0 + sc2) + sh2
        ffn = _peer(h2, w_qp[l], sub_keys[l], expert_u[l], expert_v[l])
        x = _layernorm(DEEPNORM_ALPHA * x + (1.0 + gt2) * ffn, ln2_g[l], ln2_b[l])
    return x
```

```cpp
#include <hip/hip_runtime.h>
#include <hip/hip_cooperative_groups.h>
#include <cstdio>
#include <cstdint>
namespace cg = cooperative_groups;

typedef unsigned short bf16;
typedef short bf16x8 __attribute__((ext_vector_type(8)));
typedef float f32x4 __attribute__((ext_vector_type(4)));
typedef float f32x16 __attribute__((ext_vector_type(16)));
typedef unsigned u32x4 __attribute__((ext_vector_type(4)));
typedef unsigned u32x2 __attribute__((ext_vector_type(2)));
#define LAS __attribute__((address_space(3)))

constexpr int S = 8192, D = 2048, AW = 1024, NH = 16, HD = 64, INW = 4096;
constexpr int SG = 64, SP = 16, SN = 64;
constexpr int PH = 8, NE = 16384;
constexpr float LN_EPS = 1e-5f;
constexpr float DN_ALPHA = 1.189207115002721f;
constexpr int NTHREADS = 512, NWAVES = 8;
constexpr int LDS_BYTES = 143360;

constexpr size_t MiB = 1u << 20, KiB = 1u << 10;
constexpr size_t OFF_MOD = 0, OFF_AR = 64 * KiB, OFF_AI = 80 * KiB, OFF_BBAR = 128 * KiB, OFF_CMT = 384 * KiB, OFF_SKB = 640 * KiB;
constexpr size_t OFF_ROPEC = 1 * MiB, OFF_ROPES = 2 * MiB, OFF_LSE = 3 * MiB, OFF_IDX = 5 * MiB, OFF_GATE = 9 * MiB;
constexpr size_t OFF_WIN = 16 * MiB, OFF_WGLU = 32 * MiB, OFF_WOUT = 34 * MiB, OFF_WQP = 42 * MiB;
constexpr size_t OFF_EU = 64 * MiB, OFF_EV = 128 * MiB, OFF_HB = 192 * MiB, OFF_Z = 224 * MiB, OFF_OP = 288 * MiB;
constexpr size_t OFF_MIX = 336 * MiB, OFF_YB = 368 * MiB, OFF_PRE = 384 * MiB, WS_NEED = 448 * MiB;

struct Params {
    const float* x; const float* c; const int* pos; const float* w_ada; const float* b_ada; const float* w_in;
    const float* lam_re; const float* lam_im; const float* log_dt; const float* b_re; const float* b_im; const float* c_re; const float* c_im;
    const float* ssm_d; const float* w_glu; const float* b_glu; const float* g_attn; const float* g_ssm; const float* w_out;
    const float* ln1_g; const float* ln1_b; const float* w_qp; const float* sub_keys; const float* expert_u; const float* expert_v;
    const float* ln2_g; const float* ln2_b;
    float* out; unsigned char* ws;
};

__device__ __forceinline__ unsigned f2bf(float f) { unsigned u = __float_as_uint(f); return (u + 0x7fffu + ((u >> 16) & 1u)) >> 16; }
__device__ __forceinline__ unsigned pk2(float lo, float hi) { return f2bf(lo) | (f2bf(hi) << 16); }
__device__ __forceinline__ float bf2f(unsigned b) { return __uint_as_float(b << 16); }
__device__ __forceinline__ float bflo(unsigned w) { return __uint_as_float(w << 16); }
__device__ __forceinline__ float bfhi(unsigned w) { return __uint_as_float(w & 0xffff0000u); }
__device__ __forceinline__ float wave_sum(float v) {
#pragma unroll
    for (int o = 1; o < 64; o <<= 1) v += __shfl_xor(v, o);
    return v;
}
__device__ __forceinline__ float gelu_exact(float x) { return 0.5f * x * (1.f + erff(x * 0.70710678118654752f)); }
__device__ __forceinline__ f32x4 mfma16(bf16x8 a, bf16x8 b, f32x4 c) { return __builtin_amdgcn_mfma_f32_16x16x32_bf16(a, b, c, 0, 0, 0); }

__device__ __forceinline__ void sincos_d(double x, double& s, double& c) {
    const double TWO_OVER_PI = 0.63661977236758134308, PIO2_HI = 1.57079632679489655800, PIO2_LO = 6.12323399573676603587e-17;
    const double q = __builtin_rint(x * TWO_OVER_PI);
    double r = __builtin_fma(-q, PIO2_HI, x); r = __builtin_fma(-q, PIO2_LO, r);
    const double r2 = r * r;
    double sp = -1.0 / 1307674368000.0;
    sp = sp * r2 + 1.0 / 6227020800.0; sp = sp * r2 - 1.0 / 39916800.0; sp = sp * r2 + 1.0 / 362880.0; sp = sp * r2 - 1.0 / 5040.0;
    sp = sp * r2 + 1.0 / 120.0; sp = sp * r2 - 1.0 / 6.0; sp = sp * r2 + 1.0;
    const double sr = sp * r;
    double cp = 1.0 / 20922789888000.0;
    cp = cp * r2 - 1.0 / 87178291200.0; cp = cp * r2 + 1.0 / 479001600.0; cp = cp * r2 - 1.0 / 3628800.0; cp = cp * r2 + 1.0 / 40320.0;
    cp = cp * r2 - 1.0 / 720.0; cp = cp * r2 + 1.0 / 24.0; cp = cp * r2 - 0.5; cp = cp * r2 + 1.0;
    const long long qi = (long long)q; const int m = (int)(qi & 3);
    s = (m == 0) ? sr : (m == 1) ? cp : (m == 2) ? -sr : -cp;
    c = (m == 0) ? cp : (m == 1) ? -sr : (m == 2) ? -cp : sr;
}

__device__ __forceinline__ void transpose_item(const float* W, int K, int N, bf16* WT, const float* ksc0, const float* ksc1, int ksplit, LAS float* scr, int item, int lane) {
    const int nblk = N / 32, kb = item / nblk, nb = item % nblk, k0 = 64 * kb, n0 = 32 * nb;
#pragma unroll 8
    for (int i = 0; i < 32; ++i) {
        const int kk = 2 * i + (lane >> 5);
        float v = W[(size_t)(k0 + kk) * N + n0 + (lane & 31)];
        if (ksc0) { const int kg = k0 + kk; v *= (kg < ksplit) ? ksc0[kg] : ksc1[kg - ksplit]; }
        scr[kk * 33 + (lane & 31)] = v;
    }
    const int cc = lane & 7;
#pragma unroll
    for (int j = 0; j < 4; ++j) {
        const int n = (lane >> 3) + 8 * j; const LAS float* s = scr + (8 * cc) * 33 + n;
        u32x4 o; o.x = pk2(s[0 * 33], s[1 * 33]); o.y = pk2(s[2 * 33], s[3 * 33]); o.z = pk2(s[4 * 33], s[5 * 33]); o.w = pk2(s[6 * 33], s[7 * 33]);
        *(u32x4*)(WT + (size_t)(n0 + n) * K + k0 + 8 * cc) = o;
    }
}

__device__ __forceinline__ void phase_prep(const Params& P, LAS unsigned char* lds, int tid, int lane, int wave, int bid, int G) {
    unsigned char* ws = P.ws;
    {
        LAS float* red = (LAS float*)lds;
        float* MOD = (float*)(ws + OFF_MOD);
        for (int it = bid; it < 192; it += G) {
            const int col = it * 64 + lane, r0 = wave * 256;
            float acc = 0.f;
#pragma unroll 8
            for (int i = 0; i < 256; ++i) {
                const float cv = P.c[r0 + i];
                const float sl = cv / (1.f + expf(-cv));
                acc += sl * P.w_ada[(size_t)(r0 + i) * (6 * D) + col];
            }
            red[wave * 64 + lane] = acc;
            __syncthreads();
            if (wave == 0) {
                float s = P.b_ada[col];
#pragma unroll
                for (int w = 0; w < 8; ++w) s += red[w * 64 + lane];
                MOD[col] = s;
            }
            __syncthreads();
        }
    }
    __syncthreads();
    const int gw = bid * NWAVES + wave, NGW = G * NWAVES;
    LAS float* scr = (LAS float*)(lds + wave * 8704);
    constexpr int I_WIN = (D / 64) * (INW / 32), I_GLU = (AW / 64) * (AW / 32), I_OUT = (D / 64) * (D / 32), I_QP = (D / 64) * (D / 32);
    constexpr int I_EXP = 2 * NE, I_SK = 64, I_ROPE = S * 32 / 64, I_S5 = SG;
    constexpr int NITEMS = I_WIN + I_GLU + I_OUT + I_QP + I_EXP + I_SK + I_ROPE + I_S5;
    for (int it = gw; it < NITEMS; it += NGW) {
        int r = it;
        if (r < I_WIN) { transpose_item(P.w_in, D, INW, (bf16*)(ws + OFF_WIN), nullptr, nullptr, 0, scr, r, lane); continue; } r -= I_WIN;
        if (r < I_GLU) { transpose_item(P.w_glu, AW, AW, (bf16*)(ws + OFF_WGLU), nullptr, nullptr, 0, scr, r, lane); continue; } r -= I_GLU;
        if (r < I_OUT) { transpose_item(P.w_out, D, D, (bf16*)(ws + OFF_WOUT), P.g_attn, P.g_ssm, AW, scr, r, lane); continue; } r -= I_OUT;
        if (r < I_QP) { transpose_item(P.w_qp, D, D, (bf16*)(ws + OFF_WQP), nullptr, nullptr, 0, scr, r, lane); continue; } r -= I_QP;
        if (r < I_EXP) {
            const float* src = (r < NE) ? (P.expert_u + (size_t)r * D) : (P.expert_v + (size_t)(r - NE) * D);
            bf16* dst = (r < NE) ? ((bf16*)(ws + OFF_EU) + (size_t)r * D) : ((bf16*)(ws + OFF_EV) + (size_t)(r - NE) * D);
#pragma unroll
            for (int j = 0; j < 4; ++j) {
                const int e0 = 8 * (lane + 64 * j);
                const f32x4 a = *(const f32x4*)(src + e0), b = *(const f32x4*)(src + e0 + 4);
                u32x4 o; o.x = pk2(a.x, a.y); o.y = pk2(a.z, a.w); o.z = pk2(b.x, b.y); o.w = pk2(b.z, b.w);
                *(u32x4*)(dst + e0) = o;
            }
            continue;
        } r -= I_EXP;
        if (r < I_SK) {
            const int e0 = r * 512 + lane * 8;
            const f32x4 a = *(const f32x4*)(P.sub_keys + e0), b = *(const f32x4*)(P.sub_keys + e0 + 4);
            u32x4 o; o.x = pk2(a.x, a.y); o.y = pk2(a.z, a.w); o.z = pk2(b.x, b.y); o.w = pk2(b.z, b.w);
            *(u32x4*)((bf16*)(ws + OFF_SKB) + e0) = o;
            continue;
        } r -= I_SK;
        if (r < I_ROPE) {
            const int e = r * 64 + lane, s = e >> 5, j = e & 31;
            const double RJ = 0.74989420933245582730;
            double f = 1.0;
            for (int q = 0; q < j; ++q) f *= RJ;
            const double ang = (double)P.pos[s] * f;
            double sn, cs; sincos_d(ang, sn, cs);
            ((float*)(ws + OFF_ROPEC))[e] = (float)cs; ((float*)(ws + OFF_ROPES))[e] = (float)sn;
            continue;
        } r -= I_ROPE;
        {
            const int g = r, n = lane;
            const double dt = exp((double)P.log_dt[g]);
            const double lr = (double)P.lam_re[g * SN + n], li = (double)P.lam_im[g * SN + n];
            const double mag = exp(lr * dt);
            double sn, cs; sincos_d(li * dt, sn, cs);
            const double ar = mag * cs, ai = mag * sn;
            const double den = lr * lr + li * li;
            const double cr = ((ar - 1.0) * lr + ai * li) / den, ci = (ai * lr - (ar - 1.0) * li) / den;
            ((float*)(ws + OFF_AR))[g * SN + n] = (float)ar; ((float*)(ws + OFF_AI))[g * SN + n] = (float)ai;
            bf16* BB = (bf16*)(ws + OFF_BBAR) + (size_t)g * 128 * 16;
            for (int p = 0; p < SP; ++p) {
                const double br = (double)P.b_re[(g * SN + n) * SP + p], bi = (double)P.b_im[(g * SN + n) * SP + p];
                BB[n * 16 + p] = (bf16)f2bf((float)(cr * br - ci * bi));
                BB[(64 + n) * 16 + p] = (bf16)f2bf((float)(cr * bi + ci * br));
            }
            bf16* CM = (bf16*)(ws + OFF_CMT) + (size_t)g * 16 * 128;
            for (int p = 0; p < SP; ++p) {
                CM[p * 128 + n] = (bf16)f2bf(P.c_re[(g * SP + p) * SN + n]);
                CM[p * 128 + 64 + n] = (bf16)f2bf(-P.c_im[(g * SP + p) * SN + n]);
            }
        }
    }
}

__device__ __forceinline__ void phase_ln1(const Params& P, int lane, int gw, int NGW) {
    const float* MOD = (const float*)(P.ws + OFF_MOD);
    bf16* HB = (bf16*)(P.ws + OFF_HB);
    for (int m = gw; m < S; m += NGW) {
        const f32x4* xr = (const f32x4*)(P.x + (size_t)m * D) + lane;
        f32x4 v[8]; float s = 0.f;
#pragma unroll
        for (int j = 0; j < 8; ++j) { v[j] = xr[64 * j]; s += (v[j].x + v[j].y) + (v[j].z + v[j].w); }
        const float mean = wave_sum(s) * (1.f / D); float s2 = 0.f;
#pragma unroll
        for (int j = 0; j < 8; ++j) { v[j] = v[j] - mean; s2 += (v[j].x * v[j].x + v[j].y * v[j].y) + (v[j].z * v[j].z + v[j].w * v[j].w); }
        const float rstd = 1.f / sqrtf(wave_sum(s2) * (1.f / D) + LN_EPS);
        u32x2* o8 = (u32x2*)(HB + (size_t)m * D) + lane;
#pragma unroll
        for (int j = 0; j < 8; ++j) {
            const int c0 = 4 * (lane + 64 * j);
            const f32x4 sh = *(const f32x4*)(MOD + c0), sc = *(const f32x4*)(MOD + D + c0);
            const f32x4 y = v[j] * rstd * (sc + 1.f) + sh;
            u32x2 w; w.x = pk2(y.x, y.y); w.y = pk2(y.z, y.w);
            o8[64 * j] = w;
        }
    }
}

template <class Epi>
__device__ __forceinline__ void gemm_simple(const bf16* A, int lda, const bf16* Bt, int ldb, int M, int N, int K, const Epi& epi, int lane, int wave, int bid, int G) {
    const int tilesN = N / 256, tilesM = M / 128, ntiles = tilesM * tilesN;
    for (int it = bid; it < ntiles; it += G) {
        const int tm = it / tilesN, tn = it % tilesN;
        const int row0 = tm * 128 + (wave >> 2) * 64, col0 = tn * 256 + (wave & 3) * 64;
        f32x4 acc[4][4];
#pragma unroll
        for (int a = 0; a < 4; ++a)
#pragma unroll
            for (int b = 0; b < 4; ++b) acc[a][b] = (f32x4){0.f, 0.f, 0.f, 0.f};
        const bf16* ap = A + (size_t)(row0 + (lane & 15)) * lda + 8 * (lane >> 4);
        const bf16* bp = Bt + (size_t)(col0 + (lane & 15)) * ldb + 8 * (lane >> 4);
#pragma unroll 2
        for (int k = 0; k < K; k += 32) {
            bf16x8 a[4], b[4];
#pragma unroll
            for (int i = 0; i < 4; ++i) a[i] = *(const bf16x8*)(ap + (size_t)(16 * i) * lda + k);
#pragma unroll
            for (int i = 0; i < 4; ++i) b[i] = *(const bf16x8*)(bp + (size_t)(16 * i) * ldb + k);
#pragma unroll
            for (int mi = 0; mi < 4; ++mi)
#pragma unroll
                for (int ni = 0; ni < 4; ++ni) acc[mi][ni] = mfma16(b[ni], a[mi], acc[mi][ni]);
        }
#pragma unroll
        for (int mi = 0; mi < 4; ++mi)
#pragma unroll
            for (int ni = 0; ni < 4; ++ni) epi(acc[mi][ni], row0 + 16 * mi + (lane & 15), col0 + 16 * ni + 4 * (lane >> 4));
    }
}
struct EpiStoreBf16 { bf16* O; int ldc;
    __device__ __forceinline__ void operator()(const f32x4& v, int m, int n) const { u32x2 w; w.x = pk2(v.x, v.y); w.y = pk2(v.z, v.w); *(u32x2*)(O + (size_t)m * ldc + n) = w; } };
struct EpiOutProj { const float* x; const float* gt1; float* pre;
    __device__ __forceinline__ void operator()(const f32x4& v, int m, int n) const {
        const f32x4 xv = *(const f32x4*)(x + (size_t)m * D + n), g = *(const f32x4*)(gt1 + n);
        *(f32x4*)(pre + (size_t)m * D + n) = xv * DN_ALPHA + (g + 1.f) * v; } };

__device__ __forceinline__ void phase_rope(const Params& P, int tid, int bid, int G) {
    bf16* Z = (bf16*)(P.ws + OFF_Z);
    const float* RC = (const float*)(P.ws + OFF_ROPEC); const float* RS = (const float*)(P.ws + OFF_ROPES);
    const int total = S * 2 * NH * 4;
    for (int it = bid * NTHREADS + tid; it < total; it += G * NTHREADS) {
        const int jq = it & 3, h = (it >> 2) & 15, qk = (it >> 6) & 1, t = it >> 7;
        bf16* p1 = Z + (size_t)t * INW + qk * AW + h * HD + 8 * jq; bf16* p2 = p1 + 32;
        const u32x4 a = *(const u32x4*)p1, b = *(const u32x4*)p2;
        const f32x4 c0 = *(const f32x4*)(RC + t * 32 + 8 * jq), c1 = *(const f32x4*)(RC + t * 32 + 8 * jq + 4);
        const f32x4 s0 = *(const f32x4*)(RS + t * 32 + 8 * jq), s1 = *(const f32x4*)(RS + t * 32 + 8 * jq + 4);
        const float cs[8] = {c0.x, c0.y, c0.z, c0.w, c1.x, c1.y, c1.z, c1.w}, sn[8] = {s0.x, s0.y, s0.z, s0.w, s1.x, s1.y, s1.z, s1.w};
        const unsigned aw[4] = {a.x, a.y, a.z, a.w}, bw[4] = {b.x, b.y, b.z, b.w};
        unsigned o1[4], o2[4];
#pragma unroll
        for (int w = 0; w < 4; ++w) {
            const float x1l = bflo(aw[w]), x1h = bfhi(aw[w]), x2l = bflo(bw[w]), x2h = bfhi(bw[w]);
            o1[w] = pk2(x1l * cs[2 * w] - x2l * sn[2 * w], x1h * cs[2 * w + 1] - x2h * sn[2 * w + 1]);
            o2[w] = pk2(x2l * cs[2 * w] + x1l * sn[2 * w], x2h * cs[2 * w + 1] + x1h * sn[2 * w + 1]);
        }
        *(u32x4*)p1 = (u32x4){o1[0], o1[1], o1[2], o1[3]}; *(u32x4*)p2 = (u32x4){o2[0], o2[1], o2[2], o2[3]};
    }
}

template <bool EMIT>
__device__ __forceinline__ void s5_pass(const Params& P, LAS unsigned char* buw, int g, int lane, int tbase, float ar, float ai, float& hr, float& hi,
                                        const bf16x8 (&bb)[4], const bf16x8 (&cm)[4], float dsk) {
    const bf16* Z = (const bf16*)(P.ws + OFF_Z);
    bf16* YB = (bf16*)(P.ws + OFF_YB);
    LAS float* BU = (LAS float*)buw;
    for (int ch = 0; ch < 32; ++ch) {
        const int t0 = tbase + 32 * ch;
        const bf16x8 ua = *(const bf16x8*)(Z + (size_t)(t0 + (lane & 31)) * INW + 3 * AW + 16 * g + 8 * (lane >> 5));
#pragma unroll
        for (int nt = 0; nt < 4; ++nt) {
            f32x16 acc;
#pragma unroll
            for (int i = 0; i < 16; ++i) acc[i] = 0.f;
            acc = __builtin_amdgcn_mfma_f32_32x32x16_bf16(ua, bb[nt], acc, 0, 0, 0);
#pragma unroll
            for (int r = 0; r < 16; ++r) {
                const int t = (r & 3) + 8 * (r >> 2) + 4 * (lane >> 5);
                BU[t * 128 + 32 * nt + (lane & 31)] = acc[r];
            }
        }
#pragma unroll 4
        for (int t = 0; t < 32; ++t) {
            const float br = BU[t * 128 + lane], bi = BU[t * 128 + 64 + lane];
            const float nr = ar * hr - ai * hi + br, ni = ar * hi + ai * hr + bi;
            hr = nr; hi = ni;
            if (EMIT) {
                LAS unsigned short* Hrow = (LAS unsigned short*)(buw + t * 512);
                const int c0 = (lane >> 3), c1 = 8 + (lane >> 3), sw = t & 15;
                Hrow[((c0 ^ sw) << 3) + (lane & 7)] = (unsigned short)f2bf(hr);
                Hrow[((c1 ^ sw) << 3) + (lane & 7)] = (unsigned short)f2bf(hi);
            }
        }
        if (EMIT) {
#pragma unroll
            for (int mt = 0; mt < 2; ++mt) {
                f32x4 acc = {0.f, 0.f, 0.f, 0.f};
                const int trow = 16 * mt + (lane & 15);
#pragma unroll
                for (int ks = 0; ks < 4; ++ks) {
                    const int cch = 4 * ks + (lane >> 4);
                    const bf16x8 ha = *(const LAS bf16x8*)(buw + trow * 512 + ((cch ^ (trow & 15)) << 4));
                    acc = mfma16(ha, cm[ks], acc);
                }
#pragma unroll
                for (int r = 0; r < 4; ++r) {
                    const int t = t0 + 16 * mt + 4 * (lane >> 4) + r;
                    const float u = bf2f(Z[(size_t)t * INW + 3 * AW + 16 * g + (lane & 15)]);
                    const float y = acc[r] + dsk * u;
                    YB[(size_t)t * AW + 16 * g + (lane & 15)] = (bf16)f2bf(gelu_exact(y));
                }
            }
        }
    }
}
__device__ __forceinline__ void s5_group(const Params& P, LAS unsigned char* lds, int g, int lane, int wave) {
    const float ar = ((const float*)(P.ws + OFF_AR))[g * SN + lane], ai = ((const float*)(P.ws + OFF_AI))[g * SN + lane];
    const bf16* BB = (const bf16*)(P.ws + OFF_BBAR) + (size_t)g * 128 * 16;
    const bf16* CM = (const bf16*)(P.ws + OFF_CMT) + (size_t)g * 16 * 128;
    bf16x8 bb[4], cm[4];
#pragma unroll
    for (int nt = 0; nt < 4; ++nt) bb[nt] = *(const bf16x8*)(BB + (32 * nt + (lane & 31)) * 16 + 8 * (lane >> 5));
#pragma unroll
    for (int ks = 0; ks < 4; ++ks) cm[ks] = *(const bf16x8*)(CM + (lane & 15) * 128 + 32 * ks + 8 * (lane >> 4));
    const float dsk = P.ssm_d[g * SP + (lane & 15)];
    LAS unsigned char* buw = lds + wave * 16384;
    LAS float* E = (LAS float*)(lds + 131072);
    float hr = 0.f, hi = 0.f;
    s5_pass<false>(P, buw, g, lane, wave * 1024, ar, ai, hr, hi, bb, cm, dsk);
    E[wave * 128 + lane] = hr; E[wave * 128 + 64 + lane] = hi;
    __syncthreads();
    float pr = ar, pi = ai;
#pragma unroll
    for (int i = 0; i < 10; ++i) { const float nr = pr * pr - pi * pi, ni = 2.f * pr * pi; pr = nr; pi = ni; }
    hr = 0.f; hi = 0.f;
    for (int v = 0; v < wave; ++v) {
        const float er = E[v * 128 + lane], ei = E[v * 128 + 64 + lane];
        const float nr = pr * hr - pi * hi + er, ni = pr * hi + pi * hr + ei;
        hr = nr; hi = ni;
    }
    s5_pass<true>(P, buw, g, lane, wave * 1024, ar, ai, hr, hi, bb, cm, dsk);
    __syncthreads();
}

constexpr int VT_STRIDE = 592, P_STRIDE = 336, VT_BYTES = 64 * VT_STRIDE, PW_BYTES = 16 * P_STRIDE;
__device__ __forceinline__ void attn_tile(const Params& P, LAS unsigned char* lds, int it, int tid, int lane, int wave) {
    const int pi = it >> 10, rem = it & 1023, h = rem >> 6, cb = rem & 63;
    const int d = (pi == 0) ? 1 : (pi == 1) ? 4 : 16, lognb = (pi == 0) ? 6 : (pi == 1) ? 4 : 2;
    const int r = cb >> lognb, n = cb & ((1 << lognb) - 1);
    const bf16* Z = (const bf16*)(P.ws + OFF_Z);
    LAS unsigned char* Vt = lds; LAS unsigned char* Pw = lds + VT_BYTES + wave * PW_BYTES;
    for (int e = tid; e < 64 * 16; e += NTHREADS) { const int dim = e >> 4, kk = e & 15; *(LAS unsigned*)(Vt + dim * VT_STRIDE + 512 + kk * 4) = 0u; }
    {
        const int key = tid >> 1, half = tid & 1;
        int cp = 128 * (n - 1) + key; cp = cp < 0 ? 0 : cp;
        const bf16* src = Z + (size_t)(cp * d + r) * INW + 2 * AW + h * HD + half * 32;
#pragma unroll
        for (int q = 0; q < 4; ++q) {
            const u32x4 v = *(const u32x4*)(src + 8 * q);
            const unsigned w[4] = {v.x, v.y, v.z, v.w};
#pragma unroll
            for (int e = 0; e < 4; ++e) {
                const int dim = half * 32 + 8 * q + 2 * e;
                *(LAS unsigned short*)(Vt + dim * VT_STRIDE + key * 2) = (unsigned short)(w[e] & 0xffffu);
                *(LAS unsigned short*)(Vt + (dim + 1) * VT_STRIDE + key * 2) = (unsigned short)(w[e] >> 16);
            }
        }
    }
    const int fr = lane & 15, fq = lane >> 4;
    const size_t tq_frag = (size_t)((128 * n + 16 * wave + fr) * d + r);
    bf16x8 qa[2];
#pragma unroll
    for (int ks = 0; ks < 2; ++ks) qa[ks] = *(const bf16x8*)(Z + tq_frag * INW + h * HD + 32 * ks + 8 * fq);
    f32x4 sc[9];
#pragma unroll
    for (int j = 0; j < 9; ++j) {
        const int kj = 16 * (wave + j) + fr;
        int cp = 128 * (n - 1) + kj; cp = cp < 0 ? 0 : cp;
        const bf16* kp = Z + (size_t)(cp * d + r) * INW + AW + h * HD + 8 * fq;
        f32x4 acc = {0.f, 0.f, 0.f, 0.f};
        acc = mfma16(qa[0], *(const bf16x8*)(kp), acc);
        acc = mfma16(qa[1], *(const bf16x8*)(kp + 32), acc);
        sc[j] = acc;
    }
    float mx[4] = {-3.0e38f, -3.0e38f, -3.0e38f, -3.0e38f};
#pragma unroll
    for (int j = 0; j < 9; ++j)
#pragma unroll
        for (int rr = 0; rr < 4; ++rr) {
            const int rel = 128 + 4 * fq + rr - 16 * j - fr;
            const int kj = 16 * (wave + j) + fr;
            const bool ok = (rel >= 0) && (rel <= 128) && (n > 0 || kj >= 128);
            const float s = ok ? sc[j][rr] * 0.125f : -1.0e30f;
            sc[j][rr] = s; mx[rr] = fmaxf(mx[rr], s);
        }
#pragma unroll
    for (int rr = 0; rr < 4; ++rr) {
#pragma unroll
        for (int o = 1; o < 16; o <<= 1) mx[rr] = fmaxf(mx[rr], __shfl_xor(mx[rr], o));
    }
    float ls[4] = {0.f, 0.f, 0.f, 0.f};
#pragma unroll
    for (int j = 0; j < 9; ++j)
#pragma unroll
        for (int rr = 0; rr < 4; ++rr) {
            const float p = __expf(sc[j][rr] - mx[rr]);
            ls[rr] += p;
            *(LAS unsigned short*)(Pw + (4 * fq + rr) * P_STRIDE + (16 * j + fr) * 2) = (unsigned short)f2bf(p);
        }
#pragma unroll
    for (int rr = 0; rr < 4; ++rr) {
#pragma unroll
        for (int o = 1; o < 16; o <<= 1) ls[rr] += __shfl_xor(ls[rr], o);
    }
    *(LAS u32x2*)(Pw + (lane >> 2) * P_STRIDE + 288 + 8 * (lane & 3)) = (u32x2){0u, 0u};
    __syncthreads();
    f32x4 oc[4];
#pragma unroll
    for (int i = 0; i < 4; ++i) oc[i] = (f32x4){0.f, 0.f, 0.f, 0.f};
#pragma unroll
    for (int ks = 0; ks < 5; ++ks) {
        const bf16x8 pa = *(const LAS bf16x8*)(Pw + fr * P_STRIDE + (32 * ks + 8 * fq) * 2);
#pragma unroll
        for (int nt = 0; nt < 4; ++nt) {
            const bf16x8 vb = *(const LAS bf16x8*)(Vt + (16 * nt + fr) * VT_STRIDE + (16 * wave + 32 * ks + 8 * fq) * 2);
            oc[nt] = mfma16(pa, vb, oc[nt]);
        }
    }
    bf16* OP = (bf16*)(P.ws + OFF_OP) + (size_t)pi * S * AW;
    float* LSE = (float*)(P.ws + OFF_LSE) + (size_t)pi * S * NH;
#pragma unroll
    for (int rr = 0; rr < 4; ++rr) {
        const size_t tq = (size_t)((128 * n + 16 * wave + 4 * fq + rr) * d + r);
        const float inv = 1.f / ls[rr];
#pragma unroll
        for (int nt = 0; nt < 4; ++nt) OP[tq * AW + h * HD + 16 * nt + fr] = (bf16)f2bf(oc[nt][rr] * inv);
        if (fr == 0) LSE[tq * NH + h] = mx[rr] + logf(ls[rr]);
    }
    __syncthreads();
}

__device__ __forceinline__ void combine_token(const Params& P, int t, int lane) {
    const bf16* OP = (const bf16*)(P.ws + OFF_OP); const float* LSE = (const float*)(P.ws + OFF_LSE);
    bf16* MIX = (bf16*)(P.ws + OFF_MIX);
    const int h = lane >> 2;
    float l0 = LSE[(size_t)(0 * S + t) * NH + h], l1 = LSE[(size_t)(1 * S + t) * NH + h], l2 = LSE[(size_t)(2 * S + t) * NH + h];
    const float m = fmaxf(l0, fmaxf(l1, l2));
    float w0 = __expf(l0 - m), w1 = __expf(l1 - m), w2 = __expf(l2 - m);
    const float inv = 1.f / (w0 + w1 + w2); w0 *= inv; w1 *= inv; w2 *= inv;
    float a[16]; float ss = 0.f;
    const size_t off = (size_t)t * AW + 16 * lane;
#pragma unroll
    for (int q = 0; q < 2; ++q) {
        const u32x4 v0 = *(const u32x4*)(OP + off + 8 * q), v1 = *(const u32x4*)(OP + (size_t)S * AW + off + 8 * q), v2 = *(const u32x4*)(OP + (size_t)2 * S * AW + off + 8 * q);
        const unsigned x0[4] = {v0.x, v0.y, v0.z, v0.w}, x1[4] = {v1.x, v1.y, v1.z, v1.w}, x2[4] = {v2.x, v2.y, v2.z, v2.w};
#pragma unroll
        for (int e = 0; e < 4; ++e) {
            const float lo = w0 * bflo(x0[e]) + w1 * bflo(x1[e]) + w2 * bflo(x2[e]);
            const float hi = w0 * bfhi(x0[e]) + w1 * bfhi(x1[e]) + w2 * bfhi(x2[e]);
            a[8 * q + 2 * e] = lo; a[8 * q + 2 * e + 1] = hi; ss += lo * lo + hi * hi;
        }
    }
    const float rs = 1.f / sqrtf(wave_sum(ss) * (1.f / AW) + LN_EPS);
#pragma unroll
    for (int q = 0; q < 2; ++q) {
        u32x4 o; o.x = pk2(a[8 * q] * rs, a[8 * q + 1] * rs); o.y = pk2(a[8 * q + 2] * rs, a[8 * q + 3] * rs);
        o.z = pk2(a[8 * q + 4] * rs, a[8 * q + 5] * rs); o.w = pk2(a[8 * q + 6] * rs, a[8 * q + 7] * rs);
        *(u32x4*)(MIX + (size_t)t * D + 16 * lane + 8 * q) = o;
    }
}
__device__ __forceinline__ void glu_strip(const Params& P, LAS unsigned char* lds, int strip, int lane, int wave) {
    const bf16* YB = (const bf16*)(P.ws + OFF_YB); const bf16* WG = (const bf16*)(P.ws + OFF_WGLU);
    bf16* MIX = (bf16*)(P.ws + OFF_MIX);
    LAS float* red = (LAS float*)lds;
    const int row0 = strip * 64, col0 = wave * 128, fr = lane & 15, fq = lane >> 4;
    f32x4 acc[4][8];
#pragma unroll
    for (int a = 0; a < 4; ++a)
#pragma unroll
        for (int b = 0; b < 8; ++b) acc[a][b] = (f32x4){0.f, 0.f, 0.f, 0.f};
    const bf16* ap = YB + (size_t)(row0 + fr) * AW + 8 * fq;
    const bf16* bp = WG + (size_t)(col0 + fr) * AW + 8 * fq;
    for (int k = 0; k < AW; k += 32) {
        bf16x8 a[4], b[8];
#pragma unroll
        for (int i = 0; i < 4; ++i) a[i] = *(const bf16x8*)(ap + (size_t)(16 * i) * AW + k);
#pragma unroll
        for (int i = 0; i < 8; ++i) b[i] = *(const bf16x8*)(bp + (size_t)(16 * i) * AW + k);
#pragma unroll
        for (int mi = 0; mi < 4; ++mi)
#pragma unroll
            for (int ni = 0; ni < 8; ++ni) acc[mi][ni] = mfma16(b[ni], a[mi], acc[mi][ni]);
    }
    float ssr[4];
#pragma unroll
    for (int mi = 0; mi < 4; ++mi) {
        float ss = 0.f;
        const int m = row0 + 16 * mi + fr;
#pragma unroll
        for (int ni = 0; ni < 8; ++ni) {
            const int nn = col0 + 16 * ni + 4 * fq;
            const u32x2 yv = *(const u32x2*)(YB + (size_t)m * AW + nn);
            const f32x4 bg = *(const f32x4*)(P.b_glu + nn);
            const float y4[4] = {bflo(yv.x), bfhi(yv.x), bflo(yv.y), bfhi(yv.y)};
            f32x4 o;
#pragma unroll
            for (int e = 0; e < 4; ++e) { const float gte = acc[mi][ni][e] + bg[e]; const float v = y4[e] / (1.f + __expf(-gte)); o[e] = v; ss += v * v; }
            acc[mi][ni] = o;
        }
        ss += __shfl_xor(ss, 16); ss += __shfl_xor(ss, 32);
        ssr[mi] = ss;
    }
    if (fq == 0) {
#pragma unroll
        for (int mi = 0; mi < 4; ++mi) red[wave * 64 + 16 * mi + fr] = ssr[mi];
    }
    __syncthreads();
#pragma unroll
    for (int mi = 0; mi < 4; ++mi) {
        float tot = 0.f;
#pragma unroll
        for (int w = 0; w < 8; ++w) tot += red[w * 64 + 16 * mi + fr];
        const float rs = 1.f / sqrtf(tot * (1.f / AW) + LN_EPS);
        const int m = row0 + 16 * mi + fr;
#pragma unroll
        for (int ni = 0; ni < 8; ++ni) {
            const int nn = col0 + 16 * ni + 4 * fq;
            u32x2 w; w.x = pk2(acc[mi][ni][0] * rs, acc[mi][ni][1] * rs); w.y = pk2(acc[mi][ni][2] * rs, acc[mi][ni][3] * rs);
            *(u32x2*)(MIX + (size_t)m * D + AW + nn) = w;
        }
    }
    __syncthreads();
}

__device__ __forceinline__ void phase_ln_mid(const Params& P, int lane, int gw, int NGW) {
    const float* MOD = (const float*)(P.ws + OFF_MOD); const float* PRE = (const float*)(P.ws + OFF_PRE);
    bf16* HB = (bf16*)(P.ws + OFF_HB);
    for (int m = gw; m < S; m += NGW) {
        const f32x4* xr = (const f32x4*)(PRE + (size_t)m * D) + lane;
        f32x4 v[8]; float s = 0.f;
#pragma unroll
        for (int j = 0; j < 8; ++j) { v[j] = xr[64 * j]; s += (v[j].x + v[j].y) + (v[j].z + v[j].w); }
        float mean = wave_sum(s) * (1.f / D); float s2 = 0.f;
#pragma unroll
        for (int j = 0; j < 8; ++j) { v[j] = v[j] - mean; s2 += (v[j].x * v[j].x + v[j].y * v[j].y) + (v[j].z * v[j].z + v[j].w * v[j].w); }
        float rstd = 1.f / sqrtf(wave_sum(s2) * (1.f / D) + LN_EPS);
        f32x4* o4 = (f32x4*)(P.out + (size_t)m * D) + lane;
        s = 0.f;
#pragma unroll
        for (int j = 0; j < 8; ++j) {
            const int c0 = 4 * (lane + 64 * j);
            const f32x4 g = *(const f32x4*)(P.ln1_g + c0), b = *(const f32x4*)(P.ln1_b + c0);
            v[j] = v[j] * rstd * g + b; o4[64 * j] = v[j];
            s += (v[j].x + v[j].y) + (v[j].z + v[j].w);
        }
        mean = wave_sum(s) * (1.f / D); s2 = 0.f;
#pragma unroll
        for (int j = 0; j < 8; ++j) { v[j] = v[j] - mean; s2 += (v[j].x * v[j].x + v[j].y * v[j].y) + (v[j].z * v[j].z + v[j].w * v[j].w); }
        rstd = 1.f / sqrtf(wave_sum(s2) * (1.f / D) + LN_EPS);
        u32x2* o8 = (u32x2*)(HB + (size_t)m * D) + lane;
#pragma unroll
        for (int j = 0; j < 8; ++j) {
            const int c0 = 4 * (lane + 64 * j);
            const f32x4 sh = *(const f32x4*)(MOD + 3 * D + c0), sc = *(const f32x4*)(MOD + 4 * D + c0);
            const f32x4 y = v[j] * rstd * (sc + 1.f) + sh;
            u32x2 w; w.x = pk2(y.x, y.y); w.y = pk2(y.z, y.w);
            o8[64 * j] = w;
        }
    }
}

__device__ __forceinline__ void phase_scores(const Params& P, int lane, int gw, int NGW) {
    const bf16* QP = (const bf16*)(P.ws + OFF_Z); const bf16* SK = (const bf16*)(P.ws + OFF_SKB);
    float* SC = (float*)(P.ws + OFF_PRE);
    const int fr = lane & 15, fq = lane >> 4;
    for (int it = gw; it < (S / 16) * PH * 2; it += NGW) {
        const int i = it & 1, h = (it >> 1) & 7, tb = it >> 4;
        const bf16* ap = QP + (size_t)(tb * 16 + fr) * D + h * 256 + i * 128 + 8 * fq;
        bf16x8 a[4];
#pragma unroll
        for (int ks = 0; ks < 4; ++ks) a[ks] = *(const bf16x8*)(ap + 32 * ks);
#pragma unroll
        for (int nt = 0; nt < 8; ++nt) {
            const bf16* bp = SK + (size_t)(i * 128 + 16 * nt + fr) * 128 + 8 * fq;
            f32x4 acc = {0.f, 0.f, 0.f, 0.f};
#pragma unroll
            for (int ks = 0; ks < 4; ++ks) acc = mfma16(*(const bf16x8*)(bp + 32 * ks), a[ks], acc);
            *(f32x4*)(SC + (size_t)(tb * 16 + fr) * D + h * 256 + i * 128 + 16 * nt + 4 * fq) = acc;
        }
    }
}

__device__ __forceinline__ unsigned sortable(float f) { const unsigned u = __float_as_uint(f); return u ^ ((u >> 31) ? 0xffffffffu : 0x80000000u); }
__device__ __forceinline__ float unsortable(unsigned k) { const unsigned u = (k & 0x80000000u) ? (k ^ 0x80000000u) : ~k; return __uint_as_float(u); }
__device__ __forceinline__ void phase_topk(const Params& P, int tid, int bid, int G) {
    const float* SC = (const float*)(P.ws + OFF_PRE);
    int* IDX = (int*)(P.ws + OFF_IDX); float* GATE = (float*)(P.ws + OFF_GATE);
    for (int it = bid * NTHREADS + tid; it < S * PH; it += G * NTHREADS) {
        const float* sp = SC + (size_t)it * 256;
        unsigned L[2][16];
#pragma unroll
        for (int i = 0; i < 2; ++i) {
#pragma unroll
            for (int a = 0; a < 16; ++a) L[i][a] = 0u;
            for (int k4 = 0; k4 < 32; ++k4) {
                const f32x4 v = *(const f32x4*)(sp + i * 128 + 4 * k4);
#pragma unroll
                for (int e = 0; e < 4; ++e) {
                    unsigned x = (sortable(v[e]) & 0xffffff80u) | (unsigned)(127 - (4 * k4 + e));
#pragma unroll
                    for (int a = 0; a < 16; ++a) { const unsigned hi = L[i][a] > x ? L[i][a] : x, lo = L[i][a] > x ? x : L[i][a]; L[i][a] = hi; x = lo; }
                }
            }
        }
        float sa[2][16]; int ia[2][16];
#pragma unroll
        for (int i = 0; i < 2; ++i)
#pragma unroll
            for (int a = 0; a < 16; ++a) { const int k = 127 - (int)(L[i][a] & 127u); ia[i][a] = k; sa[i][a] = sp[i * 128 + k]; }
        unsigned B[16];
#pragma unroll
        for (int a = 0; a < 16; ++a) B[a] = 0u;
#pragma unroll
        for (int a = 0; a < 16; ++a)
#pragma unroll
            for (int b = 0; b < 16; ++b)
                if ((a + 1) * (b + 1) <= 16) {
                    unsigned x = (sortable(sa[0][a] + sa[1][b]) & 0xffffff00u) | (unsigned)(255 - (a * 16 + b));
#pragma unroll
                    for (int q = 0; q < 16; ++q) { const unsigned hi = B[q] > x ? B[q] : x, lo = B[q] > x ? x : B[q]; B[q] = hi; x = lo; }
                }
        float gs[16]; float gm = -3.0e38f;
#pragma unroll
        for (int q = 0; q < 16; ++q) { gs[q] = unsortable(B[q] & 0xffffff00u); gm = fmaxf(gm, gs[q]); }
        float gsum = 0.f;
#pragma unroll
        for (int q = 0; q < 16; ++q) { gs[q] = __expf(gs[q] - gm); gsum += gs[q]; }
        const float ginv = 1.f / gsum;
#pragma unroll
        for (int q = 0; q < 16; ++q) {
            const int code = 255 - (int)(B[q] & 255u), a = code >> 4, b = code & 15;
            int i0 = ia[0][0], i1 = ia[1][0];
#pragma unroll
            for (int j = 1; j < 16; ++j) { i0 = (a == j) ? ia[0][j] : i0; i1 = (b == j) ? ia[1][j] : i1; }
            IDX[(size_t)it * 16 + q] = i0 * 128 + i1;
            GATE[(size_t)it * 16 + q] = gs[q] * ginv;
        }
    }
}

__device__ __forceinline__ void phase_experts(const Params& P, int lane, int gw, int NGW) {
    const bf16* HB = (const bf16*)(P.ws + OFF_HB); const bf16* EU = (const bf16*)(P.ws + OFF_EU); const bf16* EV = (const bf16*)(P.ws + OFF_EV);
    const int* IDX = (const int*)(P.ws + OFF_IDX); const float* GATE = (const float*)(P.ws + OFF_GATE);
    const float* MOD = (const float*)(P.ws + OFF_MOD);
    for (int t = gw; t < S; t += NGW) {
        float hf[32];
#pragma unroll
        for (int j = 0; j < 4; ++j) {
            const u32x4 v = *(const u32x4*)(HB + (size_t)t * D + 8 * (lane + 64 * j));
            hf[8 * j + 0] = bflo(v.x); hf[8 * j + 1] = bfhi(v.x); hf[8 * j + 2] = bflo(v.y); hf[8 * j + 3] = bfhi(v.y);
            hf[8 * j + 4] = bflo(v.z); hf[8 * j + 5] = bfhi(v.z); hf[8 * j + 6] = bflo(v.w); hf[8 * j + 7] = bfhi(v.w);
        }
        float y[32];
#pragma unroll
        for (int i = 0; i < 32; ++i) y[i] = 0.f;
        const int id0 = IDX[(size_t)t * 128 + lane], id1 = IDX[(size_t)t * 128 + 64 + lane];
        const float g0 = GATE[(size_t)t * 128 + lane], g1 = GATE[(size_t)t * 128 + 64 + lane];
        for (int k = 0; k < 128; k += 2) {
            int e[2]; float gt[2];
#pragma unroll
            for (int q = 0; q < 2; ++q) {
                const int kk = k + q;
                e[q] = (kk < 64) ? __builtin_amdgcn_readlane(id0, kk & 63) : __builtin_amdgcn_readlane(id1, kk & 63);
                gt[q] = __uint_as_float((kk < 64) ? __builtin_amdgcn_readlane(__float_as_uint(g0), kk & 63) : __builtin_amdgcn_readlane(__float_as_uint(g1), kk & 63));
            }
            u32x4 uu[2][4], vv[2][4];
#pragma unroll
            for (int q = 0; q < 2; ++q)
#pragma unroll
                for (int j = 0; j < 4; ++j) {
                    uu[q][j] = *(const u32x4*)(EU + (size_t)e[q] * D + 8 * (lane + 64 * j));
                    vv[q][j] = *(const u32x4*)(EV + (size_t)e[q] * D + 8 * (lane + 64 * j));
                }
#pragma unroll
            for (int q = 0; q < 2; ++q) {
                float dt = 0.f;
#pragma unroll
                for (int j = 0; j < 4; ++j) {
                    const unsigned w[4] = {uu[q][j].x, uu[q][j].y, uu[q][j].z, uu[q][j].w};
#pragma unroll
                    for (int i = 0; i < 4; ++i) dt += hf[8 * j + 2 * i] * bflo(w[i]) + hf[8 * j + 2 * i + 1] * bfhi(w[i]);
                }
                dt = wave_sum(dt);
                const float wgt = gt[q] * gelu_exact(dt);
#pragma unroll
                for (int j = 0; j < 4; ++j) {
                    const unsigned w[4] = {vv[q][j].x, vv[q][j].y, vv[q][j].z, vv[q][j].w};
#pragma unroll
                    for (int i = 0; i < 4; ++i) { y[8 * j + 2 * i] += wgt * bflo(w[i]); y[8 * j + 2 * i + 1] += wgt * bfhi(w[i]); }
                }
            }
        }
        float* orow = P.out + (size_t)t * D;
        float s = 0.f;
#pragma unroll
        for (int j = 0; j < 4; ++j) {
            const int c0 = 8 * (lane + 64 * j);
#pragma unroll
            for (int q = 0; q < 2; ++q) {
                const f32x4 xv = *(const f32x4*)(orow + c0 + 4 * q), g = *(const f32x4*)(MOD + 5 * D + c0 + 4 * q);
#pragma unroll
                for (int i = 0; i < 4; ++i) { const float v = DN_ALPHA * xv[i] + (1.f + g[i]) * y[8 * j + 4 * q + i]; y[8 * j + 4 * q + i] = v; s += v; }
            }
        }
        const float mean = wave_sum(s) * (1.f / D); float s2 = 0.f;
#pragma unroll
        for (int i = 0; i < 32; ++i) { y[i] -= mean; s2 += y[i] * y[i]; }
        const float rstd = 1.f / sqrtf(wave_sum(s2) * (1.f / D) + LN_EPS);
#pragma unroll
        for (int j = 0; j < 4; ++j) {
            const int c0 = 8 * (lane + 64 * j);
#pragma unroll
            for (int q = 0; q < 2; ++q) {
                const f32x4 g = *(const f32x4*)(P.ln2_g + c0 + 4 * q), b = *(const f32x4*)(P.ln2_b + c0 + 4 * q);
                f32x4 o;
#pragma unroll
                for (int i = 0; i < 4; ++i) o[i] = y[8 * j + 4 * q + i] * rstd * g[i] + b[i];
                *(f32x4*)(orow + c0 + 4 * q) = o;
            }
        }
    }
}

__global__ void __launch_bounds__(NTHREADS) hymba_fwd(Params P) {
    extern __shared__ __attribute__((aligned(16))) unsigned char lds_raw[];
    LAS unsigned char* lds = (LAS unsigned char*)lds_raw;
    cg::grid_group grid = cg::this_grid();
    const int tid = threadIdx.x, lane = tid & 63, wave = __builtin_amdgcn_readfirstlane(tid >> 6);
    const int bid = blockIdx.x, G = gridDim.x, gw = bid * NWAVES + wave, NGW = G * NWAVES;
    unsigned char* ws = P.ws;

    phase_prep(P, lds, tid, lane, wave, bid, G);
    grid.sync();
    phase_ln1(P, lane, gw, NGW);
    grid.sync();
    { EpiStoreBf16 e{(bf16*)(ws + OFF_Z), INW}; gemm_simple((const bf16*)(ws + OFF_HB), D, (const bf16*)(ws + OFF_WIN), D, S, INW, D, e, lane, wave, bid, G); }
    grid.sync();
    phase_rope(P, tid, bid, G);
    grid.sync();
    {
        for (int g = bid; g < SG; g += G) s5_group(P, lds, g, lane, wave);
        for (int it = bid; it < 3 * NH * 64; it += G) attn_tile(P, lds, it, tid, lane, wave);
    }
    grid.sync();
    {
        const int nGlu = (G >= 256) ? 128 : (G / 2 > 0 ? G / 2 : 1);
        if (bid < nGlu) { for (int st = bid; st < S / 64; st += nGlu) glu_strip(P, lds, st, lane, wave); }
        if (G == 1 || bid >= nGlu) {
            const int cb = (G == 1) ? 0 : bid - nGlu, cn = (G == 1) ? 1 : G - nGlu;
            for (int t = cb * NWAVES + wave; t < S; t += cn * NWAVES) combine_token(P, t, lane);
        }
    }
    grid.sync();
    { EpiOutProj e{P.x, (const float*)(ws + OFF_MOD) + 2 * D, (float*)(ws + OFF_PRE)}; gemm_simple((const bf16*)(ws + OFF_MIX), D, (const bf16*)(ws + OFF_WOUT), D, S, D, D, e, lane, wave, bid, G); }
    grid.sync();
    phase_ln_mid(P, lane, gw, NGW);
    grid.sync();
    { EpiStoreBf16 e{(bf16*)(ws + OFF_Z), D}; gemm_simple((const bf16*)(ws + OFF_HB), D, (const bf16*)(ws + OFF_WQP), D, S, D, D, e, lane, wave, bid, G); }
    grid.sync();
    phase_scores(P, lane, gw, NGW);
    grid.sync();
    phase_topk(P, tid, bid, G);
    grid.sync();
    phase_experts(P, lane, gw, NGW);
}

extern "C" void kernel_launch(void* const* d_in, const int* in_sizes, int n_in, void* d_out, int out_size, void* d_ws, size_t ws_size, hipStream_t stream) {
    static int grid_blocks = 0;
    if (grid_blocks == 0) {
        if (n_in != 27 || ws_size < WS_NEED) { fprintf(stderr, "kernel_launch: unexpected n_in %d or ws_size %zu (need %zu)\n", n_in, ws_size, (size_t)WS_NEED); grid_blocks = -1; return; }
        int dev = 0, cus = 0, per_cu = 0;
        (void)hipGetDevice(&dev);
        (void)hipDeviceGetAttribute(&cus, hipDeviceAttributeMultiprocessorCount, dev);
        (void)hipFuncSetAttribute((const void*)hymba_fwd, hipFuncAttributeMaxDynamicSharedMemorySize, LDS_BYTES);
        if (hipOccupancyMaxActiveBlocksPerMultiprocessor(&per_cu, (const void*)hymba_fwd, NTHREADS, LDS_BYTES) != hipSuccess || per_cu < 1) per_cu = 1;
        grid_blocks = cus * per_cu;
        fprintf(stderr, "kernel_launch: cus %d per_cu %d grid %d\n", cus, per_cu, grid_blocks);
    }
    if (grid_blocks < 0) return;
    Params p{};
    p.x = (const float*)d_in[0]; p.c = (const float*)d_in[1]; p.pos = (const int*)d_in[2]; p.w_ada = (const float*)d_in[3]; p.b_ada = (const float*)d_in[4];
    p.w_in = (const float*)d_in[5]; p.lam_re = (const float*)d_in[6]; p.lam_im = (const float*)d_in[7]; p.log_dt = (const float*)d_in[8];
    p.b_re = (const float*)d_in[9]; p.b_im = (const float*)d_in[10]; p.c_re = (const float*)d_in[11]; p.c_im = (const float*)d_in[12]; p.ssm_d = (const float*)d_in[13];
    p.w_glu = (const float*)d_in[14]; p.b_glu = (const float*)d_in[15]; p.g_attn = (const float*)d_in[16]; p.g_ssm = (const float*)d_in[17]; p.w_out = (const float*)d_in[18];
    p.ln1_g = (const float*)d_in[19]; p.ln1_b = (const float*)d_in[20]; p.w_qp = (const float*)d_in[21]; p.sub_keys = (const float*)d_in[22];
    p.expert_u = (const float*)d_in[23]; p.expert_v = (const float*)d_in[24]; p.ln2_g = (const float*)d_in[25]; p.ln2_b = (const float*)d_in[26];
    p.out = (float*)d_out; p.ws = (unsigned char*)d_ws;
    void* args[] = {&p};
    hipError_t e = hipLaunchCooperativeKernel((const void*)hymba_fwd, dim3(grid_blocks), dim3(NTHREADS), args, LDS_BYTES, stream);
    if (e != hipSuccess) fprintf(stderr, "cooperative launch failed: %s (grid %d)\n", hipGetErrorString(e), grid_blocks);
}
```

```cpp
#include <hip/hip_runtime.h>
#include <cstdio>
#include <cstdint>

typedef unsigned short bf16;
typedef short bf16x8 __attribute__((ext_vector_type(8)));
typedef float f32x4 __attribute__((ext_vector_type(4)));
typedef float f32x16 __attribute__((ext_vector_type(16)));
typedef unsigned u32x4 __attribute__((ext_vector_type(4)));
typedef unsigned u32x2 __attribute__((ext_vector_type(2)));
#define LAS __attribute__((address_space(3)))

constexpr int S = 8192, D = 2048, AW = 1024, NH = 16, HD = 64, INW = 4096;
constexpr int SG = 64, SP = 16, SN = 64;
constexpr int PH = 8, NE = 16384;
constexpr float LN_EPS = 1e-5f;
constexpr float DN_ALPHA = 1.189207115002721f;
constexpr int NTHREADS = 512, NWAVES = 8;
constexpr int LDS_BYTES = 143360;

constexpr size_t MiB = 1u << 20, KiB = 1u << 10;
constexpr size_t OFF_MOD = 0, OFF_AR = 64 * KiB, OFF_AI = 80 * KiB, OFF_BBAR = 128 * KiB, OFF_CMT = 384 * KiB, OFF_SKB = 640 * KiB;
constexpr size_t OFF_BAR = 704 * KiB, BAR_ZERO_BYTES = 16 * KiB;
constexpr size_t OFF_ROPEC = 1 * MiB, OFF_ROPES = 2 * MiB, OFF_LSE = 3 * MiB, OFF_IDX = 5 * MiB, OFF_GATE = 9 * MiB;
constexpr size_t OFF_WIN = 16 * MiB, OFF_WGLU = 32 * MiB, OFF_WOUT = 34 * MiB, OFF_WQP = 42 * MiB;
constexpr size_t OFF_EU = 64 * MiB, OFF_EV = 128 * MiB, OFF_HB = 192 * MiB, OFF_Z = 224 * MiB, OFF_OP = 288 * MiB;
constexpr size_t OFF_MIX = 336 * MiB, OFF_YB = 368 * MiB, OFF_PRE = 384 * MiB, WS_NEED = 448 * MiB;

struct Params {
    const float* x; const float* c; const int* pos; const float* w_ada; const float* b_ada; const float* w_in;
    const float* lam_re; const float* lam_im; const float* log_dt; const float* b_re; const float* b_im; const float* c_re; const float* c_im;
    const float* ssm_d; const float* w_glu; const float* b_glu; const float* g_attn; const float* g_ssm; const float* w_out;
    const float* ln1_g; const float* ln1_b; const float* w_qp; const float* sub_keys; const float* expert_u; const float* expert_v;
    const float* ln2_g; const float* ln2_b;
    float* out; unsigned char* ws;
};

__device__ __forceinline__ unsigned f2bf(float f) { unsigned u = __float_as_uint(f); return (u + 0x7fffu + ((u >> 16) & 1u)) >> 16; }
__device__ __forceinline__ unsigned pk2(float lo, float hi) { return f2bf(lo) | (f2bf(hi) << 16); }
__device__ __forceinline__ float bf2f(unsigned b) { return __uint_as_float(b << 16); }
__device__ __forceinline__ float bflo(unsigned w) { return __uint_as_float(w << 16); }
__device__ __forceinline__ float bfhi(unsigned w) { return __uint_as_float(w & 0xffff0000u); }
__device__ __forceinline__ float wave_sum(float v) {
#pragma unroll
    for (int o = 1; o < 64; o <<= 1) v += __shfl_xor(v, o);
    return v;
}
__device__ __forceinline__ float gelu_exact(float x) { return 0.5f * x * (1.f + erff(x * 0.70710678118654752f)); }
__device__ __forceinline__ f32x4 mfma16(bf16x8 a, bf16x8 b, f32x4 c) { return __builtin_amdgcn_mfma_f32_16x16x32_bf16(a, b, c, 0, 0, 0); }

__device__ __forceinline__ void sincos_d(double x, double& s, double& c) {
    const double TWO_OVER_PI = 0.63661977236758134308, PIO2_HI = 1.57079632679489655800, PIO2_LO = 6.12323399573676603587e-17;
    const double q = __builtin_rint(x * TWO_OVER_PI);
    double r = __builtin_fma(-q, PIO2_HI, x); r = __builtin_fma(-q, PIO2_LO, r);
    const double r2 = r * r;
    double sp = -1.0 / 1307674368000.0;
    sp = sp * r2 + 1.0 / 6227020800.0; sp = sp * r2 - 1.0 / 39916800.0; sp = sp * r2 + 1.0 / 362880.0; sp = sp * r2 - 1.0 / 5040.0;
    sp = sp * r2 + 1.0 / 120.0; sp = sp * r2 - 1.0 / 6.0; sp = sp * r2 + 1.0;
    const double sr = sp * r;
    double cp = 1.0 / 20922789888000.0;
    cp = cp * r2 - 1.0 / 87178291200.0; cp = cp * r2 + 1.0 / 479001600.0; cp = cp * r2 - 1.0 / 3628800.0; cp = cp * r2 + 1.0 / 40320.0;
    cp = cp * r2 - 1.0 / 720.0; cp = cp * r2 + 1.0 / 24.0; cp = cp * r2 - 0.5; cp = cp * r2 + 1.0;
    const long long qi = (long long)q; const int m = (int)(qi & 3);
    s = (m == 0) ? sr : (m == 1) ? cp : (m == 2) ? -sr : -cp;
    c = (m == 0) ? cp : (m == 1) ? -sr : (m == 2) ? -cp : sr;
}

#define XB_TMO      128
#define XB_XCNT(j)  (256  + 64 * (j))
#define XB_XSUB(j)  (1280 + 64 * (j))
#define XB_XGEN(j)  (2304 + 64 * (j))
#define XB_TOP      3328
#define XB_TOPGEN   3392
#define XCD_BAR_WORDS 3456
#define XB_SPIN_CAP (1u << 18)
__device__ __forceinline__ unsigned xb_ld(unsigned* p)              { return __hip_atomic_load(p, __ATOMIC_RELAXED, __HIP_MEMORY_SCOPE_AGENT); }
__device__ __forceinline__ unsigned xb_add(unsigned* p, unsigned v) { return __hip_atomic_fetch_add(p, v, __ATOMIC_RELAXED, __HIP_MEMORY_SCOPE_AGENT); }
__device__ __forceinline__ unsigned xb_xcc_id() { return (unsigned)__builtin_amdgcn_s_getreg((3 << 11) | 20) & 0xFu; }
#define XB_SPIN(cond, bar) do { unsigned _sp = 0; while (cond) { __builtin_amdgcn_s_sleep(1); \
    if ((++_sp & 255u) == 0u) { if (xb_ld(&(bar)[XB_TMO])) break; if (_sp > XB_SPIN_CAP) { atomicAdd(&(bar)[XB_TMO], 1u); break; } } } } while (0)
struct XcdBarrier { unsigned* bar; unsigned x; volatile LAS unsigned* st; };
__device__ __forceinline__ XcdBarrier xcd_barrier_post(unsigned* bar, volatile LAS unsigned* st) {
    XcdBarrier b; b.bar = bar; b.x = xb_xcc_id(); b.st = st;
    if (threadIdx.x == 0) (void)xb_add(&bar[XB_XCNT(b.x)], 1u);
    return b;
}
__device__ __forceinline__ void xcd_barrier_complete(unsigned* bar, unsigned x, unsigned& nloc, unsigned& nx) {
    const unsigned G = gridDim.x * gridDim.y * gridDim.z;
    unsigned sum, cnt, mine, sp = 0u;
    for (;;) {
        sum = 0u; cnt = 0u; mine = 0u;
#pragma unroll
        for (unsigned j = 0; j < 16; ++j) { const unsigned c = xb_ld(&bar[XB_XCNT(j)]); sum += c; cnt += (c > 0u) ? 1u : 0u; mine = (j == x) ? c : mine; }
        if (sum == G) break;
        __builtin_amdgcn_s_sleep(1);
        if ((++sp & 255u) == 0u) { if (xb_ld(&bar[XB_TMO])) break; if (sp > XB_SPIN_CAP) { atomicAdd(&bar[XB_TMO], 1u); break; } }
    }
    nloc = mine > 0u ? mine : 1u; nx = cnt > 0u ? cnt : 1u;
}
__device__ __forceinline__ void xcd_barrier(const XcdBarrier& b) {
    asm volatile("s_waitcnt vmcnt(0)" ::: "memory");
    __syncthreads();
    if (threadIdx.x == 0) {
        unsigned* bar = b.bar;
        __builtin_amdgcn_s_waitcnt(0);
        unsigned nloc = b.st[0], nx = b.st[1];
        if (nloc == 0u) { xcd_barrier_complete(bar, b.x, nloc, nx); b.st[0] = nloc; b.st[1] = nx; }
        const unsigned old = xb_add(&bar[XB_XSUB(b.x)], 1u);
        const unsigned gen = old / nloc;
        if (old + 1u == (gen + 1u) * nloc) {
            __builtin_amdgcn_fence(__ATOMIC_RELEASE, "agent");
            asm volatile("s_waitcnt vmcnt(0)" ::: "memory");
            const unsigned og = xb_add(&bar[XB_TOP], 1u);
            const unsigned tg = og / nx;
            if (og + 1u == (tg + 1u) * nx) xb_add(&bar[XB_TOPGEN], 1u);
            else XB_SPIN(xb_ld(&bar[XB_TOPGEN]) == tg, bar);
            __builtin_amdgcn_fence(__ATOMIC_ACQUIRE, "agent");
            xb_add(&bar[XB_XGEN(b.x)], 1u);
            asm volatile("s_waitcnt vmcnt(0)" ::: "memory");
        } else {
            XB_SPIN(xb_ld(&bar[XB_XGEN(b.x)]) == gen, bar);
            __builtin_amdgcn_fence(__ATOMIC_ACQUIRE, "agent");
            asm volatile("s_waitcnt vmcnt(0)" ::: "memory");
        }
    }
    __syncthreads();
}

__device__ __forceinline__ void transpose_item(const float* W, int K, int N, bf16* WT, const float* ksc0, const float* ksc1, int ksplit, LAS float* scr, int item, int lane) {
    const int nblk = N / 32, kb = item / nblk, nb = item % nblk, k0 = 64 * kb, n0 = 32 * nb;
#pragma unroll 8
    for (int i = 0; i < 32; ++i) {
        const int kk = 2 * i + (lane >> 5);
        float v = W[(size_t)(k0 + kk) * N + n0 + (lane & 31)];
        if (ksc0) { const int kg = k0 + kk; v *= (kg < ksplit) ? ksc0[kg] : ksc1[kg - ksplit]; }
        scr[kk * 33 + (lane & 31)] = v;
    }
    const int cc = lane & 7;
#pragma unroll
    for (int j = 0; j < 4; ++j) {
        const int n = (lane >> 3) + 8 * j; const LAS float* s = scr + (8 * cc) * 33 + n;
        u32x4 o; o.x = pk2(s[0 * 33], s[1 * 33]); o.y = pk2(s[2 * 33], s[3 * 33]); o.z = pk2(s[4 * 33], s[5 * 33]); o.w = pk2(s[6 * 33], s[7 * 33]);
        *(u32x4*)(WT + (size_t)(n0 + n) * K + k0 + 8 * cc) = o;
    }
}

__device__ __forceinline__ void phase_prep(const Params& P, LAS unsigned char* lds, int tid, int lane, int wave, int bid, int G) {
    unsigned char* ws = P.ws;
    {
        LAS float* red = (LAS float*)lds;
        float* MOD = (float*)(ws + OFF_MOD);
        for (int it = bid; it < 192; it += G) {
            const int col = it * 64 + lane, r0 = wave * 256;
            float acc = 0.f;
#pragma unroll 8
            for (int i = 0; i < 256; ++i) {
                const float cv = P.c[r0 + i];
                const float sl = cv / (1.f + expf(-cv));
                acc += sl * P.w_ada[(size_t)(r0 + i) * (6 * D) + col];
            }
            red[wave * 64 + lane] = acc;
            __syncthreads();
            if (wave == 0) {
                float s = P.b_ada[col];
#pragma unroll
                for (int w = 0; w < 8; ++w) s += red[w * 64 + lane];
                MOD[col] = s;
            }
            __syncthreads();
        }
    }
    __syncthreads();
    const int gw = bid * NWAVES + wave, NGW = G * NWAVES;
    LAS float* scr = (LAS float*)(lds + wave * 8704);
    constexpr int I_WIN = (D / 64) * (INW / 32), I_GLU = (AW / 64) * (AW / 32), I_OUT = (D / 64) * (D / 32), I_QP = (D / 64) * (D / 32);
    constexpr int I_EXP = 2 * NE, I_SK = 64, I_ROPE = S * 32 / 64, I_S5 = SG;
    constexpr int NITEMS = I_WIN + I_GLU + I_OUT + I_QP + I_EXP + I_SK + I_ROPE + I_S5;
    for (int it = gw; it < NITEMS; it += NGW) {
        int r = it;
        if (r < I_WIN) { transpose_item(P.w_in, D, INW, (bf16*)(ws + OFF_WIN), nullptr, nullptr, 0, scr, r, lane); continue; } r -= I_WIN;
        if (r < I_GLU) { transpose_item(P.w_glu, AW, AW, (bf16*)(ws + OFF_WGLU), nullptr, nullptr, 0, scr, r, lane); continue; } r -= I_GLU;
        if (r < I_OUT) { transpose_item(P.w_out, D, D, (bf16*)(ws + OFF_WOUT), P.g_attn, P.g_ssm, AW, scr, r, lane); continue; } r -= I_OUT;
        if (r < I_QP) { transpose_item(P.w_qp, D, D, (bf16*)(ws + OFF_WQP), nullptr, nullptr, 0, scr, r, lane); continue; } r -= I_QP;
        if (r < I_EXP) {
            const float* src = (r < NE) ? (P.expert_u + (size_t)r * D) : (P.expert_v + (size_t)(r - NE) * D);
            bf16* dst = (r < NE) ? ((bf16*)(ws + OFF_EU) + (size_t)r * D) : ((bf16*)(ws + OFF_EV) + (size_t)(r - NE) * D);
#pragma unroll
            for (int j = 0; j < 4; ++j) {
                const int e0 = 8 * (lane + 64 * j);
                const f32x4 a = *(const f32x4*)(src + e0), b = *(const f32x4*)(src + e0 + 4);
                u32x4 o; o.x = pk2(a.x, a.y); o.y = pk2(a.z, a.w); o.z = pk2(b.x, b.y); o.w = pk2(b.z, b.w);
                *(u32x4*)(dst + e0) = o;
            }
            continue;
        } r -= I_EXP;
        if (r < I_SK) {
            const int e0 = r * 512 + lane * 8;
            const f32x4 a = *(const f32x4*)(P.sub_keys + e0), b = *(const f32x4*)(P.sub_keys + e0 + 4);
            u32x4 o; o.x = pk2(a.x, a.y); o.y = pk2(a.z, a.w); o.z = pk2(b.x, b.y); o.w = pk2(b.z, b.w);
            *(u32x4*)((bf16*)(ws + OFF_SKB) + e0) = o;
            continue;
        } r -= I_SK;
        if (r < I_ROPE) {
            const int e = r * 64 + lane, s = e >> 5, j = e & 31;
            const double RJ = 0.74989420933245582730;
            double f = 1.0;
            for (int q = 0; q < j; ++q) f *= RJ;
            const double ang = (double)P.pos[s] * f;
            double sn, cs; sincos_d(ang, sn, cs);
            ((float*)(ws + OFF_ROPEC))[e] = (float)cs; ((float*)(ws + OFF_ROPES))[e] = (float)sn;
            continue;
        } r -= I_ROPE;
        {
            const int g = r, n = lane;
            const double dt = exp((double)P.log_dt[g]);
            const double lr = (double)P.lam_re[g * SN + n], li = (double)P.lam_im[g * SN + n];
            const double mag = exp(lr * dt);
            double sn, cs; sincos_d(li * dt, sn, cs);
            const double ar = mag * cs, ai = mag * sn;
            const double den = lr * lr + li * li;
            const double cr = ((ar - 1.0) * lr + ai * li) / den, ci = (ai * lr - (ar - 1.0) * li) / den;
            ((float*)(ws + OFF_AR))[g * SN + n] = (float)ar; ((float*)(ws + OFF_AI))[g * SN + n] = (float)ai;
            bf16* BB = (bf16*)(ws + OFF_BBAR) + (size_t)g * 128 * 16;
            for (int p = 0; p < SP; ++p) {
                const double br = (double)P.b_re[(g * SN + n) * SP + p], bi = (double)P.b_im[(g * SN + n) * SP + p];
                BB[n * 16 + p] = (bf16)f2bf((float)(cr * br - ci * bi));
                BB[(64 + n) * 16 + p] = (bf16)f2bf((float)(cr * bi + ci * br));
            }
            bf16* CM = (bf16*)(ws + OFF_CMT) + (size_t)g * 16 * 128;
            for (int p = 0; p < SP; ++p) {
                CM[p * 128 + n] = (bf16)f2bf(P.c_re[(g * SP + p) * SN + n]);
                CM[p * 128 + 64 + n] = (bf16)f2bf(-P.c_im[(g * SP + p) * SN + n]);
            }
        }
    }
}

__device__ __forceinline__ void phase_ln1(const Params& P, int lane, int gw, int NGW) {
    const float* MOD = (const float*)(P.ws + OFF_MOD);
    bf16* HB = (bf16*)(P.ws + OFF_HB);
    for (int m = gw; m < S; m += NGW) {
        const f32x4* xr = (const f32x4*)(P.x + (size_t)m * D) + lane;
        f32x4 v[8]; float s = 0.f;
#pragma unroll
        for (int j = 0; j < 8; ++j) { v[j] = xr[64 * j]; s += (v[j].x + v[j].y) + (v[j].z + v[j].w); }
        const float mean = wave_sum(s) * (1.f / D); float s2 = 0.f;
#pragma unroll
        for (int j = 0; j < 8; ++j) { v[j] = v[j] - mean; s2 += (v[j].x * v[j].x + v[j].y * v[j].y) + (v[j].z * v[j].z + v[j].w * v[j].w); }
        const float rstd = 1.f / sqrtf(wave_sum(s2) * (1.f / D) + LN_EPS);
        u32x2* o8 = (u32x2*)(HB + (size_t)m * D) + lane;
#pragma unroll
        for (int j = 0; j < 8; ++j) {
            const int c0 = 4 * (lane + 64 * j);
            const f32x4 sh = *(const f32x4*)(MOD + c0), sc = *(const f32x4*)(MOD + D + c0);
            const f32x4 y = v[j] * rstd * (sc + 1.f) + sh;
            u32x2 w; w.x = pk2(y.x, y.y); w.y = pk2(y.z, y.w);
            o8[64 * j] = w;
        }
    }
}

template <class Epi>
__device__ __forceinline__ void gemm_simple(const bf16* A, int lda, const bf16* Bt, int ldb, int M, int N, int K, const Epi& epi, int lane, int wave, int bid, int G) {
    const int tilesN = N / 256, tilesM = M / 128, ntiles = tilesM * tilesN;
    for (int it = bid; it < ntiles; it += G) {
        const int tm = it / tilesN, tn = it % tilesN;
        const int row0 = tm * 128 + (wave >> 2) * 64, col0 = tn * 256 + (wave & 3) * 64;
        f32x4 acc[4][4];
#pragma unroll
        for (int a = 0; a < 4; ++a)
#pragma unroll
            for (int b = 0; b < 4; ++b) acc[a][b] = (f32x4){0.f, 0.f, 0.f, 0.f};
        const bf16* ap = A + (size_t)(row0 + (lane & 15)) * lda + 8 * (lane >> 4);
        const bf16* bp = Bt + (size_t)(col0 + (lane & 15)) * ldb + 8 * (lane >> 4);
#pragma unroll 2
        for (int k = 0; k < K; k += 32) {
            bf16x8 a[4], b[4];
#pragma unroll
            for (int i = 0; i < 4; ++i) a[i] = *(const bf16x8*)(ap + (size_t)(16 * i) * lda + k);
#pragma unroll
            for (int i = 0; i < 4; ++i) b[i] = *(const bf16x8*)(bp + (size_t)(16 * i) * ldb + k);
#pragma unroll
            for (int mi = 0; mi < 4; ++mi)
#pragma unroll
                for (int ni = 0; ni < 4; ++ni) acc[mi][ni] = mfma16(b[ni], a[mi], acc[mi][ni]);
        }
#pragma unroll
        for (int mi = 0; mi < 4; ++mi)
#pragma unroll
            for (int ni = 0; ni < 4; ++ni) epi(acc[mi][ni], row0 + 16 * mi + (lane & 15), col0 + 16 * ni + 4 * (lane >> 4));
    }
}
struct EpiStoreBf16 { bf16* O; int ldc;
    __device__ __forceinline__ void operator()(const f32x4& v, int m, int n) const { u32x2 w; w.x = pk2(v.x, v.y); w.y = pk2(v.z, v.w); *(u32x2*)(O + (size_t)m * ldc + n) = w; } };
struct EpiOutProj { const float* x; const float* gt1; float* pre;
    __device__ __forceinline__ void operator()(const f32x4& v, int m, int n) const {
        const f32x4 xv = *(const f32x4*)(x + (size_t)m * D + n), g = *(const f32x4*)(gt1 + n);
        *(f32x4*)(pre + (size_t)m * D + n) = xv * DN_ALPHA + (g + 1.f) * v; } };

__device__ __forceinline__ void phase_rope(const Params& P, int tid, int bid, int G) {
    bf16* Z = (bf16*)(P.ws + OFF_Z);
    const float* RC = (const float*)(P.ws + OFF_ROPEC); const float* RS = (const float*)(P.ws + OFF_ROPES);
    const int total = S * 2 * NH * 4;
    for (int it = bid * NTHREADS + tid; it < total; it += G * NTHREADS) {
        const int jq = it & 3, h = (it >> 2) & 15, qk = (it >> 6) & 1, t = it >> 7;
        bf16* p1 = Z + (size_t)t * INW + qk * AW + h * HD + 8 * jq; bf16* p2 = p1 + 32;
        const u32x4 a = *(const u32x4*)p1, b = *(const u32x4*)p2;
        const f32x4 c0 = *(const f32x4*)(RC + t * 32 + 8 * jq), c1 = *(const f32x4*)(RC + t * 32 + 8 * jq + 4);
        const f32x4 s0 = *(const f32x4*)(RS + t * 32 + 8 * jq), s1 = *(const f32x4*)(RS + t * 32 + 8 * jq + 4);
        const float cs[8] = {c0.x, c0.y, c0.z, c0.w, c1.x, c1.y, c1.z, c1.w}, sn[8] = {s0.x, s0.y, s0.z, s0.w, s1.x, s1.y, s1.z, s1.w};
        const unsigned aw[4] = {a.x, a.y, a.z, a.w}, bw[4] = {b.x, b.y, b.z, b.w};
        unsigned o1[4], o2[4];
#pragma unroll
        for (int w = 0; w < 4; ++w) {
            const float x1l = bflo(aw[w]), x1h = bfhi(aw[w]), x2l = bflo(bw[w]), x2h = bfhi(bw[w]);
            o1[w] = pk2(x1l * cs[2 * w] - x2l * sn[2 * w], x1h * cs[2 * w + 1] - x2h * sn[2 * w + 1]);
            o2[w] = pk2(x2l * cs[2 * w] + x1l * sn[2 * w], x2h * cs[2 * w + 1] + x1h * sn[2 * w + 1]);
        }
        *(u32x4*)p1 = (u32x4){o1[0], o1[1], o1[2], o1[3]}; *(u32x4*)p2 = (u32x4){o2[0], o2[1], o2[2], o2[3]};
    }
}

template <bool EMIT>
__device__ __forceinline__ void s5_pass(const Params& P, LAS unsigned char* buw, int g, int lane, int tbase, float ar, float ai, float& hr, float& hi,
                                        const bf16x8 (&bb)[4], const bf16x8 (&cm)[4], float dsk) {
    const bf16* Z = (const bf16*)(P.ws + OFF_Z);
    bf16* YB = (bf16*)(P.ws + OFF_YB);
    LAS float* BU = (LAS float*)buw;
    for (int ch = 0; ch < 32; ++ch) {
        const int t0 = tbase + 32 * ch;
        const bf16x8 ua = *(const bf16x8*)(Z + (size_t)(t0 + (lane & 31)) * INW + 3 * AW + 16 * g + 8 * (lane >> 5));
#pragma unroll
        for (int nt = 0; nt < 4; ++nt) {
            f32x16 acc;
#pragma unroll
            for (int i = 0; i < 16; ++i) acc[i] = 0.f;
            acc = __builtin_amdgcn_mfma_f32_32x32x16_bf16(ua, bb[nt], acc, 0, 0, 0);
#pragma unroll
            for (int r = 0; r < 16; ++r) {
                const int t = (r & 3) + 8 * (r >> 2) + 4 * (lane >> 5);
                BU[t * 128 + 32 * nt + (lane & 31)] = acc[r];
            }
        }
#pragma unroll 4
        for (int t = 0; t < 32; ++t) {
            const float br = BU[t * 128 + lane], bi = BU[t * 128 + 64 + lane];
            const float nr = ar * hr - ai * hi + br, ni = ar * hi + ai * hr + bi;
            hr = nr; hi = ni;
            if (EMIT) {
                LAS unsigned short* Hrow = (LAS unsigned short*)(buw + t * 512);
                const int c0 = (lane >> 3), c1 = 8 + (lane >> 3), sw = t & 15;
                Hrow[((c0 ^ sw) << 3) + (lane & 7)] = (unsigned short)f2bf(hr);
                Hrow[((c1 ^ sw) << 3) + (lane & 7)] = (unsigned short)f2bf(hi);
            }
        }
        if (EMIT) {
#pragma unroll
            for (int mt = 0; mt < 2; ++mt) {
                f32x4 acc = {0.f, 0.f, 0.f, 0.f};
                const int trow = 16 * mt + (lane & 15);
#pragma unroll
                for (int ks = 0; ks < 4; ++ks) {
                    const int cch = 4 * ks + (lane >> 4);
                    const bf16x8 ha = *(const LAS bf16x8*)(buw + trow * 512 + ((cch ^ (trow & 15)) << 4));
                    acc = mfma16(ha, cm[ks], acc);
                }
#pragma unroll
                for (int r = 0; r < 4; ++r) {
                    const int t = t0 + 16 * mt + 4 * (lane >> 4) + r;
                    const float u = bf2f(Z[(size_t)t * INW + 3 * AW + 16 * g + (lane & 15)]);
                    const float y = acc[r] + dsk * u;
                    YB[(size_t)t * AW + 16 * g + (lane & 15)] = (bf16)f2bf(gelu_exact(y));
                }
            }
        }
    }
}
__device__ __forceinline__ void s5_group(const Params& P, LAS unsigned char* lds, int g, int lane, int wave) {
    const float ar = ((const float*)(P.ws + OFF_AR))[g * SN + lane], ai = ((const float*)(P.ws + OFF_AI))[g * SN + lane];
    const bf16* BB = (const bf16*)(P.ws + OFF_BBAR) + (size_t)g * 128 * 16;
    const bf16* CM = (const bf16*)(P.ws + OFF_CMT) + (size_t)g * 16 * 128;
    bf16x8 bb[4], cm[4];
#pragma unroll
    for (int nt = 0; nt < 4; ++nt) bb[nt] = *(const bf16x8*)(BB + (32 * nt + (lane & 31)) * 16 + 8 * (lane >> 5));
#pragma unroll
    for (int ks = 0; ks < 4; ++ks) cm[ks] = *(const bf16x8*)(CM + (lane & 15) * 128 + 32 * ks + 8 * (lane >> 4));
    const float dsk = P.ssm_d[g * SP + (lane & 15)];
    LAS unsigned char* buw = lds + wave * 16384;
    LAS float* E = (LAS float*)(lds + 131072);
    float hr = 0.f, hi = 0.f;
    s5_pass<false>(P, buw, g, lane, wave * 1024, ar, ai, hr, hi, bb, cm, dsk);
    E[wave * 128 + lane] = hr; E[wave * 128 + 64 + lane] = hi;
    __syncthreads();
    float pr = ar, pi = ai;
#pragma unroll
    for (int i = 0; i < 10; ++i) { const float nr = pr * pr - pi * pi, ni = 2.f * pr * pi; pr = nr; pi = ni; }
    hr = 0.f; hi = 0.f;
    for (int v = 0; v < wave; ++v) {
        const float er = E[v * 128 + lane], ei = E[v * 128 + 64 + lane];
        const float nr = pr * hr - pi * hi + er, ni = pr * hi + pi * hr + ei;
        hr = nr; hi = ni;
    }
    s5_pass<true>(P, buw, g, lane, wave * 1024, ar, ai, hr, hi, bb, cm, dsk);
    __syncthreads();
}

constexpr int VT_STRIDE = 592, P_STRIDE = 336, VT_BYTES = 64 * VT_STRIDE, PW_BYTES = 16 * P_STRIDE;
__device__ __forceinline__ void attn_tile(const Params& P, LAS unsigned char* lds, int it, int tid, int lane, int wave) {
    const int pi = it >> 10, rem = it & 1023, h = rem >> 6, cb = rem & 63;
    const int d = (pi == 0) ? 1 : (pi == 1) ? 4 : 16, lognb = (pi == 0) ? 6 : (pi == 1) ? 4 : 2;
    const int r = cb >> lognb, n = cb & ((1 << lognb) - 1);
    const bf16* Z = (const bf16*)(P.ws + OFF_Z);
    LAS unsigned char* Vt = lds; LAS unsigned char* Pw = lds + VT_BYTES + wave * PW_BYTES;
    for (int e = tid; e < 64 * 16; e += NTHREADS) { const int dim = e >> 4, kk = e & 15; *(LAS unsigned*)(Vt + dim * VT_STRIDE + 512 + kk * 4) = 0u; }
    {
        const int key = tid >> 1, half = tid & 1;
        int cp = 128 * (n - 1) + key; cp = cp < 0 ? 0 : cp;
        const bf16* src = Z + (size_t)(cp * d + r) * INW + 2 * AW + h * HD + half * 32;
#pragma unroll
        for (int q = 0; q < 4; ++q) {
            const u32x4 v = *(const u32x4*)(src + 8 * q);
            const unsigned w[4] = {v.x, v.y, v.z, v.w};
#pragma unroll
            for (int e = 0; e < 4; ++e) {
                const int dim = half * 32 + 8 * q + 2 * e;
                *(LAS unsigned short*)(Vt + dim * VT_STRIDE + key * 2) = (unsigned short)(w[e] & 0xffffu);
                *(LAS unsigned short*)(Vt + (dim + 1) * VT_STRIDE + key * 2) = (unsigned short)(w[e] >> 16);
            }
        }
    }
    const int fr = lane & 15, fq = lane >> 4;
    const size_t tq_frag = (size_t)((128 * n + 16 * wave + fr) * d + r);
    bf16x8 qa[2];
#pragma unroll
    for (int ks = 0; ks < 2; ++ks) qa[ks] = *(const bf16x8*)(Z + tq_frag * INW + h * HD + 32 * ks + 8 * fq);
    f32x4 sc[9];
#pragma unroll
    for (int j = 0; j < 9; ++j) {
        const int kj = 16 * (wave + j) + fr;
        int cp = 128 * (n - 1) + kj; cp = cp < 0 ? 0 : cp;
        const bf16* kp = Z + (size_t)(cp * d + r) * INW + AW + h * HD + 8 * fq;
        f32x4 acc = {0.f, 0.f, 0.f, 0.f};
        acc = mfma16(qa[0], *(const bf16x8*)(kp), acc);
        acc = mfma16(qa[1], *(const bf16x8*)(kp + 32), acc);
        sc[j] = acc;
    }
    float mx[4] = {-3.0e38f, -3.0e38f, -3.0e38f, -3.0e38f};
#pragma unroll
    for (int j = 0; j < 9; ++j)
#pragma unroll
        for (int rr = 0; rr < 4; ++rr) {
            const int rel = 128 + 4 * fq + rr - 16 * j - fr;
            const int kj = 16 * (wave + j) + fr;
            const bool ok = (rel >= 0) && (rel <= 128) && (n > 0 || kj >= 128);
            const float s = ok ? sc[j][rr] * 0.125f : -1.0e30f;
            sc[j][rr] = s; mx[rr] = fmaxf(mx[rr], s);
        }
#pragma unroll
    for (int rr = 0; rr < 4; ++rr) {
#pragma unroll
        for (int o = 1; o < 16; o <<= 1) mx[rr] = fmaxf(mx[rr], __shfl_xor(mx[rr], o));
    }
    float ls[4] = {0.f, 0.f, 0.f, 0.f};
#pragma unroll
    for (int j = 0; j < 9; ++j)
#pragma unroll
        for (int rr = 0; rr < 4; ++rr) {
            const float p = __expf(sc[j][rr] - mx[rr]);
            ls[rr] += p;
            *(LAS unsigned short*)(Pw + (4 * fq + rr) * P_STRIDE + (16 * j + fr) * 2) = (unsigned short)f2bf(p);
        }
#pragma unroll
    for (int rr = 0; rr < 4; ++rr) {
#pragma unroll
        for (int o = 1; o < 16; o <<= 1) ls[rr] += __shfl_xor(ls[rr], o);
    }
    *(LAS u32x2*)(Pw + (lane >> 2) * P_STRIDE + 288 + 8 * (lane & 3)) = (u32x2){0u, 0u};
    __syncthreads();
    f32x4 oc[4];
#pragma unroll
    for (int i = 0; i < 4; ++i) oc[i] = (f32x4){0.f, 0.f, 0.f, 0.f};
#pragma unroll
    for (int ks = 0; ks < 5; ++ks) {
        const bf16x8 pa = *(const LAS bf16x8*)(Pw + fr * P_STRIDE + (32 * ks + 8 * fq) * 2);
#pragma unroll
        for (int nt = 0; nt < 4; ++nt) {
            const bf16x8 vb = *(const LAS bf16x8*)(Vt + (16 * nt + fr) * VT_STRIDE + (16 * wave + 32 * ks + 8 * fq) * 2);
            oc[nt] = mfma16(pa, vb, oc[nt]);
        }
    }
    bf16* OP = (bf16*)(P.ws + OFF_OP) + (size_t)pi * S * AW;
    float* LSE = (float*)(P.ws + OFF_LSE) + (size_t)pi * S * NH;
#pragma unroll
    for (int rr = 0; rr < 4; ++rr) {
        const size_t tq = (size_t)((128 * n + 16 * wave + 4 * fq + rr) * d + r);
        const float inv = 1.f / ls[rr];
#pragma unroll
        for (int nt = 0; nt < 4; ++nt) OP[tq * AW + h * HD + 16 * nt + fr] = (bf16)f2bf(oc[nt][rr] * inv);
        if (fr == 0) LSE[tq * NH + h] = mx[rr] + logf(ls[rr]);
    }
    __syncthreads();
}

__device__ __forceinline__ void combine_token(const Params& P, int t, int lane) {
    const bf16* OP = (const bf16*)(P.ws + OFF_OP); const float* LSE = (const float*)(P.ws + OFF_LSE);
    bf16* MIX = (bf16*)(P.ws + OFF_MIX);
    const int h = lane >> 2;
    float l0 = LSE[(size_t)(0 * S + t) * NH + h], l1 = LSE[(size_t)(1 * S + t) * NH + h], l2 = LSE[(size_t)(2 * S + t) * NH + h];
    const float m = fmaxf(l0, fmaxf(l1, l2));
    float w0 = __expf(l0 - m), w1 = __expf(l1 - m), w2 = __expf(l2 - m);
    const float inv = 1.f / (w0 + w1 + w2); w0 *= inv; w1 *= inv; w2 *= inv;
    float a[16]; float ss = 0.f;
    const size_t off = (size_t)t * AW + 16 * lane;
#pragma unroll
    for (int q = 0; q < 2; ++q) {
        const u32x4 v0 = *(const u32x4*)(OP + off + 8 * q), v1 = *(const u32x4*)(OP + (size_t)S * AW + off + 8 * q), v2 = *(const u32x4*)(OP + (size_t)2 * S * AW + off + 8 * q);
        const unsigned x0[4] = {v0.x, v0.y, v0.z, v0.w}, x1[4] = {v1.x, v1.y, v1.z, v1.w}, x2[4] = {v2.x, v2.y, v2.z, v2.w};
#pragma unroll
        for (int e = 0; e < 4; ++e) {
            const float lo = w0 * bflo(x0[e]) + w1 * bflo(x1[e]) + w2 * bflo(x2[e]);
            const float hi = w0 * bfhi(x0[e]) + w1 * bfhi(x1[e]) + w2 * bfhi(x2[e]);
            a[8 * q + 2 * e] = lo; a[8 * q + 2 * e + 1] = hi; ss += lo * lo + hi * hi;
        }
    }
    const float rs = 1.f / sqrtf(wave_sum(ss) * (1.f / AW) + LN_EPS);
#pragma unroll
    for (int q = 0; q < 2; ++q) {
        u32x4 o; o.x = pk2(a[8 * q] * rs, a[8 * q + 1] * rs); o.y = pk2(a[8 * q + 2] * rs, a[8 * q + 3] * rs);
        o.z = pk2(a[8 * q + 4] * rs, a[8 * q + 5] * rs); o.w = pk2(a[8 * q + 6] * rs, a[8 * q + 7] * rs);
        *(u32x4*)(MIX + (size_t)t * D + 16 * lane + 8 * q) = o;
    }
}
__device__ __forceinline__ void glu_strip(const Params& P, LAS unsigned char* lds, int strip, int lane, int wave) {
    const bf16* YB = (const bf16*)(P.ws + OFF_YB); const bf16* WG = (const bf16*)(P.ws + OFF_WGLU);
    bf16* MIX = (bf16*)(P.ws + OFF_MIX);
    LAS float* red = (LAS float*)lds;
    const int row0 = strip * 64, col0 = wave * 128, fr = lane & 15, fq = lane >> 4;
    f32x4 acc[4][8];
#pragma unroll
    for (int a = 0; a < 4; ++a)
#pragma unroll
        for (int b = 0; b < 8; ++b) acc[a][b] = (f32x4){0.f, 0.f, 0.f, 0.f};
    const bf16* ap = YB + (size_t)(row0 + fr) * AW + 8 * fq;
    const bf16* bp = WG + (size_t)(col0 + fr) * AW + 8 * fq;
    for (int k = 0; k < AW; k += 32) {
        bf16x8 a[4], b[8];
#pragma unroll
        for (int i = 0; i < 4; ++i) a[i] = *(const bf16x8*)(ap + (size_t)(16 * i) * AW + k);
#pragma unroll
        for (int i = 0; i < 8; ++i) b[i] = *(const bf16x8*)(bp + (size_t)(16 * i) * AW + k);
#pragma unroll
        for (int mi = 0; mi < 4; ++mi)
#pragma unroll
            for (int ni = 0; ni < 8; ++ni) acc[mi][ni] = mfma16(b[ni], a[mi], acc[mi][ni]);
    }
    float ssr[4];
#pragma unroll
    for (int mi = 0; mi < 4; ++mi) {
        float ss = 0.f;
        const int m = row0 + 16 * mi + fr;
#pragma unroll
        for (int ni = 0; ni < 8; ++ni) {
            const int nn = col0 + 16 * ni + 4 * fq;
            const u32x2 yv = *(const u32x2*)(YB + (size_t)m * AW + nn);
            const f32x4 bg = *(const f32x4*)(P.b_glu + nn);
            const float y4[4] = {bflo(yv.x), bfhi(yv.x), bflo(yv.y), bfhi(yv.y)};
            f32x4 o;
#pragma unroll
            for (int e = 0; e < 4; ++e) { const float gte = acc[mi][ni][e] + bg[e]; const float v = y4[e] / (1.f + __expf(-gte)); o[e] = v; ss += v * v; }
            acc[mi][ni] = o;
        }
        ss += __shfl_xor(ss, 16); ss += __shfl_xor(ss, 32);
        ssr[mi] = ss;
    }
    if (fq == 0) {
#pragma unroll
        for (int mi = 0; mi < 4; ++mi) red[wave * 64 + 16 * mi + fr] = ssr[mi];
    }
    __syncthreads();
#pragma unroll
    for (int mi = 0; mi < 4; ++mi) {
        float tot = 0.f;
#pragma unroll
        for (int w = 0; w < 8; ++w) tot += red[w * 64 + 16 * mi + fr];
        const float rs = 1.f / sqrtf(tot * (1.f / AW) + LN_EPS);
        const int m = row0 + 16 * mi + fr;
#pragma unroll
        for (int ni = 0; ni < 8; ++ni) {
            const int nn = col0 + 16 * ni + 4 * fq;
            u32x2 w; w.x = pk2(acc[mi][ni][0] * rs, acc[mi][ni][1] * rs); w.y = pk2(acc[mi][ni][2] * rs, acc[mi][ni][3] * rs);
            *(u32x2*)(MIX + (size_t)m * D + AW + nn) = w;
        }
    }
    __syncthreads();
}

__device__ __forceinline__ void phase_ln_mid(const Params& P, int lane, int gw, int NGW) {
    const float* MOD = (const float*)(P.ws + OFF_MOD); const float* PRE = (const float*)(P.ws + OFF_PRE);
    bf16* HB = (bf16*)(P.ws + OFF_HB);
    for (int m = gw; m < S; m += NGW) {
        const f32x4* xr = (const f32x4*)(PRE + (size_t)m * D) + lane;
        f32x4 v[8]; float s = 0.f;
#pragma unroll
        for (int j = 0; j < 8; ++j) { v[j] = xr[64 * j]; s += (v[j].x + v[j].y) + (v[j].z + v[j].w); }
        float mean = wave_sum(s) * (1.f / D); float s2 = 0.f;
#pragma unroll
        for (int j = 0; j < 8; ++j) { v[j] = v[j] - mean; s2 += (v[j].x * v[j].x + v[j].y * v[j].y) + (v[j].z * v[j].z + v[j].w * v[j].w); }
        float rstd = 1.f / sqrtf(wave_sum(s2) * (1.f / D) + LN_EPS);
        f32x4* o4 = (f32x4*)(P.out + (size_t)m * D) + lane;
        s = 0.f;
#pragma unroll
        for (int j = 0; j < 8; ++j) {
            const int c0 = 4 * (lane + 64 * j);
            const f32x4 g = *(const f32x4*)(P.ln1_g + c0), b = *(const f32x4*)(P.ln1_b + c0);
            v[j] = v[j] * rstd * g + b; o4[64 * j] = v[j];
            s += (v[j].x + v[j].y) + (v[j].z + v[j].w);
        }
        mean = wave_sum(s) * (1.f / D); s2 = 0.f;
#pragma unroll
        for (int j = 0; j < 8; ++j) { v[j] = v[j] - mean; s2 += (v[j].x * v[j].x + v[j].y * v[j].y) + (v[j].z * v[j].z + v[j].w * v[j].w); }
        rstd = 1.f / sqrtf(wave_sum(s2) * (1.f / D) + LN_EPS);
        u32x2* o8 = (u32x2*)(HB + (size_t)m * D) + lane;
#pragma unroll
        for (int j = 0; j < 8; ++j) {
            const int c0 = 4 * (lane + 64 * j);
            const f32x4 sh = *(const f32x4*)(MOD + 3 * D + c0), sc = *(const f32x4*)(MOD + 4 * D + c0);
            const f32x4 y = v[j] * rstd * (sc + 1.f) + sh;
            u32x2 w; w.x = pk2(y.x, y.y); w.y = pk2(y.z, y.w);
            o8[64 * j] = w;
        }
    }
}

__device__ __forceinline__ void phase_scores(const Params& P, int lane, int gw, int NGW) {
    const bf16* QP = (const bf16*)(P.ws + OFF_Z); const bf16* SK = (const bf16*)(P.ws + OFF_SKB);
    float* SC = (float*)(P.ws + OFF_PRE);
    const int fr = lane & 15, fq = lane >> 4;
    for (int it = gw; it < (S / 16) * PH * 2; it += NGW) {
        const int i = it & 1, h = (it >> 1) & 7, tb = it >> 4;
        const bf16* ap = QP + (size_t)(tb * 16 + fr) * D + h * 256 + i * 128 + 8 * fq;
        bf16x8 a[4];
#pragma unroll
        for (int ks = 0; ks < 4; ++ks) a[ks] = *(const bf16x8*)(ap + 32 * ks);
#pragma unroll
        for (int nt = 0; nt < 8; ++nt) {
            const bf16* bp = SK + (size_t)(i * 128 + 16 * nt + fr) * 128 + 8 * fq;
            f32x4 acc = {0.f, 0.f, 0.f, 0.f};
#pragma unroll
            for (int ks = 0; ks < 4; ++ks) acc = mfma16(*(const bf16x8*)(bp + 32 * ks), a[ks], acc);
            *(f32x4*)(SC + (size_t)(tb * 16 + fr) * D + h * 256 + i * 128 + 16 * nt + 4 * fq) = acc;
        }
    }
}

__device__ __forceinline__ unsigned sortable(float f) { const unsigned u = __float_as_uint(f); return u ^ ((u >> 31) ? 0xffffffffu : 0x80000000u); }
__device__ __forceinline__ float unsortable(unsigned k) { const unsigned u = (k & 0x80000000u) ? (k ^ 0x80000000u) : ~k; return __uint_as_float(u); }
__device__ __forceinline__ void phase_topk(const Params& P, int tid, int bid, int G) {
    const float* SC = (const float*)(P.ws + OFF_PRE);
    int* IDX = (int*)(P.ws + OFF_IDX); float* GATE = (float*)(P.ws + OFF_GATE);
    for (int it = bid * NTHREADS + tid; it < S * PH; it += G * NTHREADS) {
        const float* sp = SC + (size_t)it * 256;
        unsigned L[2][16];
#pragma unroll
        for (int i = 0; i < 2; ++i) {
#pragma unroll
            for (int a = 0; a < 16; ++a) L[i][a] = 0u;
            for (int k4 = 0; k4 < 32; ++k4) {
                const f32x4 v = *(const f32x4*)(sp + i * 128 + 4 * k4);
#pragma unroll
                for (int e = 0; e < 4; ++e) {
                    unsigned x = (sortable(v[e]) & 0xffffff80u) | (unsigned)(127 - (4 * k4 + e));
#pragma unroll
                    for (int a = 0; a < 16; ++a) { const unsigned hi = L[i][a] > x ? L[i][a] : x, lo = L[i][a] > x ? x : L[i][a]; L[i][a] = hi; x = lo; }
                }
            }
        }
        float sa[2][16]; int ia[2][16];
#pragma unroll
        for (int i = 0; i < 2; ++i)
#pragma unroll
            for (int a = 0; a < 16; ++a) { const int k = 127 - (int)(L[i][a] & 127u); ia[i][a] = k; sa[i][a] = sp[i * 128 + k]; }
        unsigned B[16];
#pragma unroll
        for (int a = 0; a < 16; ++a) B[a] = 0u;
#pragma unroll
        for (int a = 0; a < 16; ++a)
#pragma unroll
            for (int b = 0; b < 16; ++b)
                if ((a + 1) * (b + 1) <= 16) {
                    unsigned x = (sortable(sa[0][a] + sa[1][b]) & 0xffffff00u) | (unsigned)(255 - (a * 16 + b));
#pragma unroll
                    for (int q = 0; q < 16; ++q) { const unsigned hi = B[q] > x ? B[q] : x, lo = B[q] > x ? x : B[q]; B[q] = hi; x = lo; }
                }
        float gs[16]; float gm = -3.0e38f;
#pragma unroll
        for (int q = 0; q < 16; ++q) { gs[q] = unsortable(B[q] & 0xffffff00u); gm = fmaxf(gm, gs[q]); }
        float gsum = 0.f;
#pragma unroll
        for (int q = 0; q < 16; ++q) { gs[q] = __expf(gs[q] - gm); gsum += gs[q]; }
        const float ginv = 1.f / gsum;
#pragma unroll
        for (int q = 0; q < 16; ++q) {
            const int code = 255 - (int)(B[q] & 255u), a = code >> 4, b = code & 15;
            int i0 = ia[0][0], i1 = ia[1][0];
#pragma unroll
            for (int j = 1; j < 16; ++j) { i0 = (a == j) ? ia[0][j] : i0; i1 = (b == j) ? ia[1][j] : i1; }
            IDX[(size_t)it * 16 + q] = i0 * 128 + i1;
            GATE[(size_t)it * 16 + q] = gs[q] * ginv;
        }
    }
}

__device__ __forceinline__ void phase_experts(const Params& P, int lane, int gw, int NGW) {
    const bf16* HB = (const bf16*)(P.ws + OFF_HB); const bf16* EU = (const bf16*)(P.ws + OFF_EU); const bf16* EV = (const bf16*)(P.ws + OFF_EV);
    const int* IDX = (const int*)(P.ws + OFF_IDX); const float* GATE = (const float*)(P.ws + OFF_GATE);
    const float* MOD = (const float*)(P.ws + OFF_MOD);
    for (int t = gw; t < S; t += NGW) {
        float hf[32];
#pragma unroll
        for (int j = 0; j < 4; ++j) {
            const u32x4 v = *(const u32x4*)(HB + (size_t)t * D + 8 * (lane + 64 * j));
            hf[8 * j + 0] = bflo(v.x); hf[8 * j + 1] = bfhi(v.x); hf[8 * j + 2] = bflo(v.y); hf[8 * j + 3] = bfhi(v.y);
            hf[8 * j + 4] = bflo(v.z); hf[8 * j + 5] = bfhi(v.z); hf[8 * j + 6] = bflo(v.w); hf[8 * j + 7] = bfhi(v.w);
        }
        float y[32];
#pragma unroll
        for (int i = 0; i < 32; ++i) y[i] = 0.f;
        const int id0 = IDX[(size_t)t * 128 + lane], id1 = IDX[(size_t)t * 128 + 64 + lane];
        const float g0 = GATE[(size_t)t * 128 + lane], g1 = GATE[(size_t)t * 128 + 64 + lane];
        for (int k = 0; k < 128; k += 2) {
            int e[2]; float gt[2];
#pragma unroll
            for (int q = 0; q < 2; ++q) {
                const int kk = k + q;
                e[q] = (kk < 64) ? __builtin_amdgcn_readlane(id0, kk & 63) : __builtin_amdgcn_readlane(id1, kk & 63);
                gt[q] = __uint_as_float((kk < 64) ? __builtin_amdgcn_readlane(__float_as_uint(g0), kk & 63) : __builtin_amdgcn_readlane(__float_as_uint(g1), kk & 63));
            }
            u32x4 uu[2][4], vv[2][4];
#pragma unroll
            for (int q = 0; q < 2; ++q)
#pragma unroll
                for (int j = 0; j < 4; ++j) {
                    uu[q][j] = *(const u32x4*)(EU + (size_t)e[q] * D + 8 * (lane + 64 * j));
                    vv[q][j] = *(const u32x4*)(EV + (size_t)e[q] * D + 8 * (lane + 64 * j));
                }
#pragma unroll
            for (int q = 0; q < 2; ++q) {
                float dt = 0.f;
#pragma unroll
                for (int j = 0; j < 4; ++j) {
                    const unsigned w[4] = {uu[q][j].x, uu[q][j].y, uu[q][j].z, uu[q][j].w};
#pragma unroll
                    for (int i = 0; i < 4; ++i) dt += hf[8 * j + 2 * i] * bflo(w[i]) + hf[8 * j + 2 * i + 1] * bfhi(w[i]);
                }
                dt = wave_sum(dt);
                const float wgt = gt[q] * gelu_exact(dt);
#pragma unroll
                for (int j = 0; j < 4; ++j) {
                    const unsigned w[4] = {vv[q][j].x, vv[q][j].y, vv[q][j].z, vv[q][j].w};
#pragma unroll
                    for (int i = 0; i < 4; ++i) { y[8 * j + 2 * i] += wgt * bflo(w[i]); y[8 * j + 2 * i + 1] += wgt * bfhi(w[i]); }
                }
            }
        }
        float* orow = P.out + (size_t)t * D;
        float s = 0.f;
#pragma unroll
        for (int j = 0; j < 4; ++j) {
            const int c0 = 8 * (lane + 64 * j);
#pragma unroll
            for (int q = 0; q < 2; ++q) {
                const f32x4 xv = *(const f32x4*)(orow + c0 + 4 * q), g = *(const f32x4*)(MOD + 5 * D + c0 + 4 * q);
#pragma unroll
                for (int i = 0; i < 4; ++i) { const float v = DN_ALPHA * xv[i] + (1.f + g[i]) * y[8 * j + 4 * q + i]; y[8 * j + 4 * q + i] = v; s += v; }
            }
        }
        const float mean = wave_sum(s) * (1.f / D); float s2 = 0.f;
#pragma unroll
        for (int i = 0; i < 32; ++i) { y[i] -= mean; s2 += y[i] * y[i]; }
        const float rstd = 1.f / sqrtf(wave_sum(s2) * (1.f / D) + LN_EPS);
#pragma unroll
        for (int j = 0; j < 4; ++j) {
            const int c0 = 8 * (lane + 64 * j);
#pragma unroll
            for (int q = 0; q < 2; ++q) {
                const f32x4 g = *(const f32x4*)(P.ln2_g + c0 + 4 * q), b = *(const f32x4*)(P.ln2_b + c0 + 4 * q);
                f32x4 o;
#pragma unroll
                for (int i = 0; i < 4; ++i) o[i] = y[8 * j + 4 * q + i] * rstd * g[i] + b[i];
                *(f32x4*)(orow + c0 + 4 * q) = o;
            }
        }
    }
}

__global__ void __launch_bounds__(NTHREADS) hymba_fwd(Params P) {
    extern __shared__ __attribute__((aligned(16))) unsigned char lds_raw[];
    LAS unsigned char* lds = (LAS unsigned char*)lds_raw;
    const int tid = threadIdx.x, lane = tid & 63, wave = __builtin_amdgcn_readfirstlane(tid >> 6);
    const int bid = blockIdx.x, G = gridDim.x, gw = bid * NWAVES + wave, NGW = G * NWAVES;
    unsigned char* ws = P.ws;
    volatile LAS unsigned* bst = (volatile LAS unsigned*)(lds + LDS_BYTES - 16);
    if (tid < 4) bst[tid] = 0u;
    __syncthreads();
    const XcdBarrier gbar = xcd_barrier_post((unsigned*)(ws + OFF_BAR), bst);
#define GRID_SYNC() xcd_barrier(gbar)

    phase_prep(P, lds, tid, lane, wave, bid, G);
    GRID_SYNC();
    phase_ln1(P, lane, gw, NGW);
    GRID_SYNC();
    { EpiStoreBf16 e{(bf16*)(ws + OFF_Z), INW}; gemm_simple((const bf16*)(ws + OFF_HB), D, (const bf16*)(ws + OFF_WIN), D, S, INW, D, e, lane, wave, bid, G); }
    GRID_SYNC();
    phase_rope(P, tid, bid, G);
    GRID_SYNC();
    {
        for (int g = bid; g < SG; g += G) s5_group(P, lds, g, lane, wave);
        for (int it = bid; it < 3 * NH * 64; it += G) attn_tile(P, lds, it, tid, lane, wave);
    }
    GRID_SYNC();
    {
        const int nGlu = (G >= 256) ? 128 : (G / 2 > 0 ? G / 2 : 1);
        if (bid < nGlu) { for (int st = bid; st < S / 64; st += nGlu) glu_strip(P, lds, st, lane, wave); }
        if (G == 1 || bid >= nGlu) {
            const int cb = (G == 1) ? 0 : bid - nGlu, cn = (G == 1) ? 1 : G - nGlu;
            for (int t = cb * NWAVES + wave; t < S; t += cn * NWAVES) combine_token(P, t, lane);
        }
    }
    GRID_SYNC();
    { EpiOutProj e{P.x, (const float*)(ws + OFF_MOD) + 2 * D, (float*)(ws + OFF_PRE)}; gemm_simple((const bf16*)(ws + OFF_MIX), D, (const bf16*)(ws + OFF_WOUT), D, S, D, D, e, lane, wave, bid, G); }
    GRID_SYNC();
    phase_ln_mid(P, lane, gw, NGW);
    GRID_SYNC();
    { EpiStoreBf16 e{(bf16*)(ws + OFF_Z), D}; gemm_simple((const bf16*)(ws + OFF_HB), D, (const bf16*)(ws + OFF_WQP), D, S, D, D, e, lane, wave, bid, G); }
    GRID_SYNC();
    phase_scores(P, lane, gw, NGW);
    GRID_SYNC();
    phase_topk(P, tid, bid, G);
    GRID_SYNC();
    phase_experts(P, lane, gw, NGW);
}

extern "C" void kernel_launch(void* const* d_in, const int* in_sizes, int n_in, void* d_out, int out_size, void* d_ws, size_t ws_size, hipStream_t stream) {
    static int grid_blocks = 0;
    if (grid_blocks == 0) {
        if (n_in != 27 || ws_size < WS_NEED) { fprintf(stderr, "kernel_launch: unexpected n_in %d or ws_size %zu (need %zu)\n", n_in, ws_size, (size_t)WS_NEED); grid_blocks = -1; return; }
        int dev = 0, cus = 0, per_cu = 0;
        (void)hipGetDevice(&dev);
        (void)hipDeviceGetAttribute(&cus, hipDeviceAttributeMultiprocessorCount, dev);
        (void)hipFuncSetAttribute((const void*)hymba_fwd, hipFuncAttributeMaxDynamicSharedMemorySize, LDS_BYTES);
        if (hipOccupancyMaxActiveBlocksPerMultiprocessor(&per_cu, (const void*)hymba_fwd, NTHREADS, LDS_BYTES) != hipSuccess || per_cu < 1) per_cu = 1;
        grid_blocks = cus;
        fprintf(stderr, "kernel_launch: cus %d per_cu %d grid %d\n", cus, per_cu, grid_blocks);
    }
    if (grid_blocks < 0) return;
    Params p{};
    p.x = (const float*)d_in[0]; p.c = (const float*)d_in[1]; p.pos = (const int*)d_in[2]; p.w_ada = (const float*)d_in[3]; p.b_ada = (const float*)d_in[4];
    p.w_in = (const float*)d_in[5]; p.lam_re = (const float*)d_in[6]; p.lam_im = (const float*)d_in[7]; p.log_dt = (const float*)d_in[8];
    p.b_re = (const float*)d_in[9]; p.b_im = (const float*)d_in[10]; p.c_re = (const float*)d_in[11]; p.c_im = (const float*)d_in[12]; p.ssm_d = (const float*)d_in[13];
    p.w_glu = (const float*)d_in[14]; p.b_glu = (const float*)d_in[15]; p.g_attn = (const float*)d_in[16]; p.g_ssm = (const float*)d_in[17]; p.w_out = (const float*)d_in[18];
    p.ln1_g = (const float*)d_in[19]; p.ln1_b = (const float*)d_in[20]; p.w_qp = (const float*)d_in[21]; p.sub_keys = (const float*)d_in[22];
    p.expert_u = (const float*)d_in[23]; p.expert_v = (const float*)d_in[24]; p.ln2_g = (const float*)d_in[25]; p.ln2_b = (const float*)d_in[26];
    p.out = (float*)d_out; p.ws = (unsigned char*)d_ws;
    if (hipMemsetAsync((unsigned char*)d_ws + OFF_BAR, 0, BAR_ZERO_BYTES, stream) != hipSuccess) { fprintf(stderr, "kernel_launch: memset of barrier words failed\n"); return; }
    hipLaunchKernelGGL(hymba_fwd, dim3(grid_blocks), dim3(NTHREADS), LDS_BYTES, stream, p);
    const hipError_t e = hipPeekAtLastError();
    if (e != hipSuccess) fprintf(stderr, "launch failed: %s (grid %d)\n", hipGetErrorString(e), grid_blocks);
}
```

```cpp
#include <hip/hip_runtime.h>
#include <cstdio>
#include <cstdint>

typedef unsigned short bf16;
typedef short bf16x8 __attribute__((ext_vector_type(8)));
typedef float f32x4 __attribute__((ext_vector_type(4)));
typedef float f32x16 __attribute__((ext_vector_type(16)));
typedef unsigned u32x4 __attribute__((ext_vector_type(4)));
typedef unsigned u32x2 __attribute__((ext_vector_type(2)));
#define LAS __attribute__((address_space(3)))

constexpr int S = 8192, D = 2048, AW = 1024, NH = 16, HD = 64, INW = 4096;
constexpr int SG = 64, SP = 16, SN = 64;
constexpr int PH = 8, NE = 16384;
constexpr float LN_EPS = 1e-5f;
constexpr float DN_ALPHA = 1.189207115002721f;
constexpr int NTHREADS = 512, NWAVES = 8;
constexpr int LDS_BYTES = 143360;

constexpr size_t MiB = 1u << 20, KiB = 1u << 10;
constexpr size_t OFF_MOD = 0, OFF_AR = 64 * KiB, OFF_AI = 80 * KiB, OFF_BBAR = 128 * KiB, OFF_CMT = 384 * KiB, OFF_SKB = 640 * KiB;
constexpr size_t OFF_BAR = 704 * KiB, BAR_ZERO_BYTES = 16 * KiB;
constexpr size_t OFF_ROPEC = 1 * MiB, OFF_ROPES = 2 * MiB, OFF_LSE = 3 * MiB, OFF_IDX = 5 * MiB, OFF_GATE = 9 * MiB;
constexpr size_t OFF_WIN = 16 * MiB, OFF_WGLU = 32 * MiB, OFF_WOUT = 34 * MiB, OFF_WQP = 42 * MiB;
constexpr size_t OFF_EU = 64 * MiB, OFF_EV = 96 * MiB, OFF_ESCU = 128 * MiB, OFF_ESCV = 129 * MiB, OFF_HB = 192 * MiB, OFF_Z = 224 * MiB, OFF_OP = 288 * MiB;
constexpr size_t OFF_MIX = 336 * MiB, OFF_YB = 368 * MiB, OFF_PRE = 384 * MiB, WS_NEED = 448 * MiB;

struct Params {
    const float* x; const float* c; const int* pos; const float* w_ada; const float* b_ada; const float* w_in;
    const float* lam_re; const float* lam_im; const float* log_dt; const float* b_re; const float* b_im; const float* c_re; const float* c_im;
    const float* ssm_d; const float* w_glu; const float* b_glu; const float* g_attn; const float* g_ssm; const float* w_out;
    const float* ln1_g; const float* ln1_b; const float* w_qp; const float* sub_keys; const float* expert_u; const float* expert_v;
    const float* ln2_g; const float* ln2_b;
    float* out; unsigned char* ws;
};

__device__ __forceinline__ unsigned f2bf(float f) { unsigned u = __float_as_uint(f); return (u + 0x7fffu + ((u >> 16) & 1u)) >> 16; }
__device__ __forceinline__ unsigned pk2(float lo, float hi) { return f2bf(lo) | (f2bf(hi) << 16); }
__device__ __forceinline__ float bf2f(unsigned b) { return __uint_as_float(b << 16); }
__device__ __forceinline__ float bflo(unsigned w) { return __uint_as_float(w << 16); }
__device__ __forceinline__ float bfhi(unsigned w) { return __uint_as_float(w & 0xffff0000u); }
__device__ __forceinline__ float wave_sum(float v) {
#pragma unroll
    for (int o = 1; o < 64; o <<= 1) v += __shfl_xor(v, o);
    return v;
}
__device__ __forceinline__ float gelu_exact(float x) { return 0.5f * x * (1.f + erff(x * 0.70710678118654752f)); }
__device__ __forceinline__ f32x4 mfma16(bf16x8 a, bf16x8 b, f32x4 c) { return __builtin_amdgcn_mfma_f32_16x16x32_bf16(a, b, c, 0, 0, 0); }

__device__ __forceinline__ void sincos_d(double x, double& s, double& c) {
    const double TWO_OVER_PI = 0.63661977236758134308, PIO2_HI = 1.57079632679489655800, PIO2_LO = 6.12323399573676603587e-17;
    const double q = __builtin_rint(x * TWO_OVER_PI);
    double r = __builtin_fma(-q, PIO2_HI, x); r = __builtin_fma(-q, PIO2_LO, r);
    const double r2 = r * r;
    double sp = -1.0 / 1307674368000.0;
    sp = sp * r2 + 1.0 / 6227020800.0; sp = sp * r2 - 1.0 / 39916800.0; sp = sp * r2 + 1.0 / 362880.0; sp = sp * r2 - 1.0 / 5040.0;
    sp = sp * r2 + 1.0 / 120.0; sp = sp * r2 - 1.0 / 6.0; sp = sp * r2 + 1.0;
    const double sr = sp * r;
    double cp = 1.0 / 20922789888000.0;
    cp = cp * r2 - 1.0 / 87178291200.0; cp = cp * r2 + 1.0 / 479001600.0; cp = cp * r2 - 1.0 / 3628800.0; cp = cp * r2 + 1.0 / 40320.0;
    cp = cp * r2 - 1.0 / 720.0; cp = cp * r2 + 1.0 / 24.0; cp = cp * r2 - 0.5; cp = cp * r2 + 1.0;
    const long long qi = (long long)q; const int m = (int)(qi & 3);
    s = (m == 0) ? sr : (m == 1) ? cp : (m == 2) ? -sr : -cp;
    c = (m == 0) ? cp : (m == 1) ? -sr : (m == 2) ? -cp : sr;
}

#define XB_TMO      128
#define XB_XCNT(j)  (256  + 64 * (j))
#define XB_XSUB(j)  (1280 + 64 * (j))
#define XB_XGEN(j)  (2304 + 64 * (j))
#define XB_TOP      3328
#define XB_TOPGEN   3392
#define XCD_BAR_WORDS 3456
#define XB_SPIN_CAP (1u << 18)
__device__ __forceinline__ unsigned xb_ld(unsigned* p)              { return __hip_atomic_load(p, __ATOMIC_RELAXED, __HIP_MEMORY_SCOPE_AGENT); }
__device__ __forceinline__ unsigned xb_add(unsigned* p, unsigned v) { return __hip_atomic_fetch_add(p, v, __ATOMIC_RELAXED, __HIP_MEMORY_SCOPE_AGENT); }
__device__ __forceinline__ unsigned xb_xcc_id() { return (unsigned)__builtin_amdgcn_s_getreg((3 << 11) | 20) & 0xFu; }
#define XB_SPIN(cond, bar) do { unsigned _sp = 0; while (cond) { __builtin_amdgcn_s_sleep(1); \
    if ((++_sp & 255u) == 0u) { if (xb_ld(&(bar)[XB_TMO])) break; if (_sp > XB_SPIN_CAP) { atomicAdd(&(bar)[XB_TMO], 1u); break; } } } } while (0)
struct XcdBarrier { unsigned* bar; unsigned x; volatile LAS unsigned* st; };
__device__ __forceinline__ XcdBarrier xcd_barrier_post(unsigned* bar, volatile LAS unsigned* st) {
    XcdBarrier b; b.bar = bar; b.x = xb_xcc_id(); b.st = st;
    if (threadIdx.x == 0) (void)xb_add(&bar[XB_XCNT(b.x)], 1u);
    return b;
}
__device__ __forceinline__ void xcd_barrier_complete(unsigned* bar, unsigned x, unsigned& nloc, unsigned& nx) {
    const unsigned G = gridDim.x * gridDim.y * gridDim.z;
    unsigned sum, cnt, mine, sp = 0u;
    for (;;) {
        sum = 0u; cnt = 0u; mine = 0u;
#pragma unroll
        for (unsigned j = 0; j < 16; ++j) { const unsigned c = xb_ld(&bar[XB_XCNT(j)]); sum += c; cnt += (c > 0u) ? 1u : 0u; mine = (j == x) ? c : mine; }
        if (sum == G) break;
        __builtin_amdgcn_s_sleep(1);
        if ((++sp & 255u) == 0u) { if (xb_ld(&bar[XB_TMO])) break; if (sp > XB_SPIN_CAP) { atomicAdd(&bar[XB_TMO], 1u); break; } }
    }
    nloc = mine > 0u ? mine : 1u; nx = cnt > 0u ? cnt : 1u;
}
__device__ __forceinline__ void xcd_barrier(const XcdBarrier& b) {
    asm volatile("s_waitcnt vmcnt(0)" ::: "memory");
    __syncthreads();
    if (threadIdx.x == 0) {
        unsigned* bar = b.bar;
        __builtin_amdgcn_s_waitcnt(0);
        unsigned nloc = b.st[0], nx = b.st[1];
        if (nloc == 0u) { xcd_barrier_complete(bar, b.x, nloc, nx); b.st[0] = nloc; b.st[1] = nx; }
        const unsigned old = xb_add(&bar[XB_XSUB(b.x)], 1u);
        const unsigned gen = old / nloc;
        if (old + 1u == (gen + 1u) * nloc) {
            __builtin_amdgcn_fence(__ATOMIC_RELEASE, "agent");
            asm volatile("s_waitcnt vmcnt(0)" ::: "memory");
            const unsigned og = xb_add(&bar[XB_TOP], 1u);
            const unsigned tg = og / nx;
            if (og + 1u == (tg + 1u) * nx) xb_add(&bar[XB_TOPGEN], 1u);
            else XB_SPIN(xb_ld(&bar[XB_TOPGEN]) == tg, bar);
            __builtin_amdgcn_fence(__ATOMIC_ACQUIRE, "agent");
            xb_add(&bar[XB_XGEN(b.x)], 1u);
            asm volatile("s_waitcnt vmcnt(0)" ::: "memory");
        } else {
            XB_SPIN(xb_ld(&bar[XB_XGEN(b.x)]) == gen, bar);
            __builtin_amdgcn_fence(__ATOMIC_ACQUIRE, "agent");
            asm volatile("s_waitcnt vmcnt(0)" ::: "memory");
        }
    }
    __syncthreads();
}

__device__ __forceinline__ void transpose_item(const float* W, int K, int N, bf16* WT, const float* ksc0, const float* ksc1, int ksplit, LAS float* scr, int item, int lane) {
    const int nblk = N / 32, kb = item / nblk, nb = item % nblk, k0 = 64 * kb, n0 = 32 * nb;
#pragma unroll 8
    for (int i = 0; i < 32; ++i) {
        const int kk = 2 * i + (lane >> 5);
        float v = W[(size_t)(k0 + kk) * N + n0 + (lane & 31)];
        if (ksc0) { const int kg = k0 + kk; v *= (kg < ksplit) ? ksc0[kg] : ksc1[kg - ksplit]; }
        scr[kk * 33 + (lane & 31)] = v;
    }
    const int cc = lane & 7;
#pragma unroll
    for (int j = 0; j < 4; ++j) {
        const int n = (lane >> 3) + 8 * j; const LAS float* s = scr + (8 * cc) * 33 + n;
        u32x4 o; o.x = pk2(s[0 * 33], s[1 * 33]); o.y = pk2(s[2 * 33], s[3 * 33]); o.z = pk2(s[4 * 33], s[5 * 33]); o.w = pk2(s[6 * 33], s[7 * 33]);
        *(u32x4*)(WT + (size_t)(n0 + n) * K + k0 + 8 * cc) = o;
    }
}

__device__ __forceinline__ void phase_prep(const Params& P, LAS unsigned char* lds, int tid, int lane, int wave, int bid, int G) {
    unsigned char* ws = P.ws;
    {
        LAS float* red = (LAS float*)lds;
        float* MOD = (float*)(ws + OFF_MOD);
        for (int it = bid; it < 192; it += G) {
            const int col = it * 64 + lane, r0 = wave * 256;
            float acc = 0.f;
#pragma unroll 8
            for (int i = 0; i < 256; ++i) {
                const float cv = P.c[r0 + i];
                const float sl = cv / (1.f + expf(-cv));
                acc += sl * P.w_ada[(size_t)(r0 + i) * (6 * D) + col];
            }
            red[wave * 64 + lane] = acc;
            __syncthreads();
            if (wave == 0) {
                float s = P.b_ada[col];
#pragma unroll
                for (int w = 0; w < 8; ++w) s += red[w * 64 + lane];
                MOD[col] = s;
            }
            __syncthreads();
        }
    }
    __syncthreads();
    const int gw = bid * NWAVES + wave, NGW = G * NWAVES;
    LAS float* scr = (LAS float*)(lds + wave * 8704);
    constexpr int I_WIN = (D / 64) * (INW / 32), I_GLU = (AW / 64) * (AW / 32), I_OUT = (D / 64) * (D / 32), I_QP = (D / 64) * (D / 32);
    constexpr int I_EXP = 2 * NE, I_SK = 64, I_ROPE = S * 32 / 64, I_S5 = SG;
    constexpr int NITEMS = I_WIN + I_GLU + I_OUT + I_QP + I_EXP + I_SK + I_ROPE + I_S5;
    for (int it = gw; it < NITEMS; it += NGW) {
        int r = it;
        if (r < I_WIN) { transpose_item(P.w_in, D, INW, (bf16*)(ws + OFF_WIN), nullptr, nullptr, 0, scr, r, lane); continue; } r -= I_WIN;
        if (r < I_GLU) { transpose_item(P.w_glu, AW, AW, (bf16*)(ws + OFF_WGLU), nullptr, nullptr, 0, scr, r, lane); continue; } r -= I_GLU;
        if (r < I_OUT) { transpose_item(P.w_out, D, D, (bf16*)(ws + OFF_WOUT), P.g_attn, P.g_ssm, AW, scr, r, lane); continue; } r -= I_OUT;
        if (r < I_QP) { transpose_item(P.w_qp, D, D, (bf16*)(ws + OFF_WQP), nullptr, nullptr, 0, scr, r, lane); continue; } r -= I_QP;
        if (r < I_EXP) {
            const bool isu = r < NE; const int er = isu ? r : r - NE;
            const float* src = (isu ? P.expert_u : P.expert_v) + (size_t)er * D;
            unsigned char* dst = ws + (isu ? OFF_EU : OFF_EV) + (size_t)er * D;
            f32x4 a[4], b[4]; float m = 0.f;
#pragma unroll
            for (int j = 0; j < 4; ++j) {
                const int e0 = 8 * (lane + 64 * j);
                a[j] = *(const f32x4*)(src + e0); b[j] = *(const f32x4*)(src + e0 + 4);
#pragma unroll
                for (int i = 0; i < 4; ++i) m = fmaxf(m, fmaxf(fabsf(a[j][i]), fabsf(b[j][i])));
            }
#pragma unroll
            for (int o = 1; o < 64; o <<= 1) m = fmaxf(m, __shfl_xor(m, o));
            const float inv = m > 0.f ? 127.f / m : 0.f;
#pragma unroll
            for (int j = 0; j < 4; ++j) {
                unsigned w0 = 0u, w1 = 0u;
#pragma unroll
                for (int i = 0; i < 4; ++i) {
                    w0 |= (unsigned)((int)rintf(a[j][i] * inv) + 128) << (8 * i);
                    w1 |= (unsigned)((int)rintf(b[j][i] * inv) + 128) << (8 * i);
                }
                *(u32x2*)(dst + 8 * (lane + 64 * j)) = (u32x2){w0, w1};
            }
            if (lane == 0) ((float*)(ws + (isu ? OFF_ESCU : OFF_ESCV)))[er] = m * (1.f / 127.f);
            continue;
        } r -= I_EXP;
        if (r < I_SK) {
            const int e0 = r * 512 + lane * 8;
            const f32x4 a = *(const f32x4*)(P.sub_keys + e0), b = *(const f32x4*)(P.sub_keys + e0 + 4);
            u32x4 o; o.x = pk2(a.x, a.y); o.y = pk2(a.z, a.w); o.z = pk2(b.x, b.y); o.w = pk2(b.z, b.w);
            *(u32x4*)((bf16*)(ws + OFF_SKB) + e0) = o;
            continue;
        } r -= I_SK;
        if (r < I_ROPE) {
            const int e = r * 64 + lane, s = e >> 5, j = e & 31;
            const double RJ = 0.74989420933245582730;
            double f = 1.0;
            for (int q = 0; q < j; ++q) f *= RJ;
            const double ang = (double)P.pos[s] * f;
            double sn, cs; sincos_d(ang, sn, cs);
            ((float*)(ws + OFF_ROPEC))[e] = (float)cs; ((float*)(ws + OFF_ROPES))[e] = (float)sn;
            continue;
        } r -= I_ROPE;
        {
            const int g = r, n = lane;
            const double dt = exp((double)P.log_dt[g]);
            const double lr = (double)P.lam_re[g * SN + n], li = (double)P.lam_im[g * SN + n];
            const double mag = exp(lr * dt);
            double sn, cs; sincos_d(li * dt, sn, cs);
            const double ar = mag * cs, ai = mag * sn;
            const double den = lr * lr + li * li;
            const double cr = ((ar - 1.0) * lr + ai * li) / den, ci = (ai * lr - (ar - 1.0) * li) / den;
            ((float*)(ws + OFF_AR))[g * SN + n] = (float)ar; ((float*)(ws + OFF_AI))[g * SN + n] = (float)ai;
            bf16* BB = (bf16*)(ws + OFF_BBAR) + (size_t)g * 128 * 16;
            for (int p = 0; p < SP; ++p) {
                const double br = (double)P.b_re[(g * SN + n) * SP + p], bi = (double)P.b_im[(g * SN + n) * SP + p];
                BB[n * 16 + p] = (bf16)f2bf((float)(cr * br - ci * bi));
                BB[(64 + n) * 16 + p] = (bf16)f2bf((float)(cr * bi + ci * br));
            }
            bf16* CM = (bf16*)(ws + OFF_CMT) + (size_t)g * 16 * 128;
            for (int p = 0; p < SP; ++p) {
                CM[p * 128 + n] = (bf16)f2bf(P.c_re[(g * SP + p) * SN + n]);
                CM[p * 128 + 64 + n] = (bf16)f2bf(-P.c_im[(g * SP + p) * SN + n]);
            }
        }
    }
}

__device__ __forceinline__ void phase_ln1(const Params& P, int lane, int gw, int NGW) {
    const float* MOD = (const float*)(P.ws + OFF_MOD);
    bf16* HB = (bf16*)(P.ws + OFF_HB);
    for (int m = gw; m < S; m += NGW) {
        const f32x4* xr = (const f32x4*)(P.x + (size_t)m * D) + lane;
        f32x4 v[8]; float s = 0.f;
#pragma unroll
        for (int j = 0; j < 8; ++j) { v[j] = xr[64 * j]; s += (v[j].x + v[j].y) + (v[j].z + v[j].w); }
        const float mean = wave_sum(s) * (1.f / D); float s2 = 0.f;
#pragma unroll
        for (int j = 0; j < 8; ++j) { v[j] = v[j] - mean; s2 += (v[j].x * v[j].x + v[j].y * v[j].y) + (v[j].z * v[j].z + v[j].w * v[j].w); }
        const float rstd = 1.f / sqrtf(wave_sum(s2) * (1.f / D) + LN_EPS);
        u32x2* o8 = (u32x2*)(HB + (size_t)m * D) + lane;
#pragma unroll
        for (int j = 0; j < 8; ++j) {
            const int c0 = 4 * (lane + 64 * j);
            const f32x4 sh = *(const f32x4*)(MOD + c0), sc = *(const f32x4*)(MOD + D + c0);
            const f32x4 y = v[j] * rstd * (sc + 1.f) + sh;
            u32x2 w; w.x = pk2(y.x, y.y); w.y = pk2(y.z, y.w);
            o8[64 * j] = w;
        }
    }
}

template <class Epi>
__device__ __forceinline__ void gemm_simple(const bf16* A, int lda, const bf16* Bt, int ldb, int M, int N, int K, const Epi& epi, int lane, int wave, int bid, int G) {
    const int tilesN = N / 256, tilesM = M / 128, ntiles = tilesM * tilesN;
    for (int it = bid; it < ntiles; it += G) {
        const int tm = it / tilesN, tn = it % tilesN;
        const int row0 = tm * 128 + (wave >> 2) * 64, col0 = tn * 256 + (wave & 3) * 64;
        f32x4 acc[4][4];
#pragma unroll
        for (int a = 0; a < 4; ++a)
#pragma unroll
            for (int b = 0; b < 4; ++b) acc[a][b] = (f32x4){0.f, 0.f, 0.f, 0.f};
        const bf16* ap = A + (size_t)(row0 + (lane & 15)) * lda + 8 * (lane >> 4);
        const bf16* bp = Bt + (size_t)(col0 + (lane & 15)) * ldb + 8 * (lane >> 4);
#pragma unroll 2
        for (int k = 0; k < K; k += 32) {
            bf16x8 a[4], b[4];
#pragma unroll
            for (int i = 0; i < 4; ++i) a[i] = *(const bf16x8*)(ap + (size_t)(16 * i) * lda + k);
#pragma unroll
            for (int i = 0; i < 4; ++i) b[i] = *(const bf16x8*)(bp + (size_t)(16 * i) * ldb + k);
#pragma unroll
            for (int mi = 0; mi < 4; ++mi)
#pragma unroll
                for (int ni = 0; ni < 4; ++ni) acc[mi][ni] = mfma16(b[ni], a[mi], acc[mi][ni]);
        }
#pragma unroll
        for (int mi = 0; mi < 4; ++mi)
#pragma unroll
            for (int ni = 0; ni < 4; ++ni) epi(acc[mi][ni], row0 + 16 * mi + (lane & 15), col0 + 16 * ni + 4 * (lane >> 4));
    }
}
struct EpiStoreBf16 { bf16* O; int ldc;
    __device__ __forceinline__ void operator()(const f32x4& v, int m, int n) const { u32x2 w; w.x = pk2(v.x, v.y); w.y = pk2(v.z, v.w); *(u32x2*)(O + (size_t)m * ldc + n) = w; } };
struct EpiOutProj { const float* x; const float* gt1; float* pre;
    __device__ __forceinline__ void operator()(const f32x4& v, int m, int n) const {
        const f32x4 xv = *(const f32x4*)(x + (size_t)m * D + n), g = *(const f32x4*)(gt1 + n);
        *(f32x4*)(pre + (size_t)m * D + n) = xv * DN_ALPHA + (g + 1.f) * v; } };

__device__ __forceinline__ void phase_rope(const Params& P, int tid, int bid, int G) {
    bf16* Z = (bf16*)(P.ws + OFF_Z);
    const float* RC = (const float*)(P.ws + OFF_ROPEC); const float* RS = (const float*)(P.ws + OFF_ROPES);
    const int total = S * 2 * NH * 4;
    for (int it = bid * NTHREADS + tid; it < total; it += G * NTHREADS) {
        const int jq = it & 3, h = (it >> 2) & 15, qk = (it >> 6) & 1, t = it >> 7;
        bf16* p1 = Z + (size_t)t * INW + qk * AW + h * HD + 8 * jq; bf16* p2 = p1 + 32;
        const u32x4 a = *(const u32x4*)p1, b = *(const u32x4*)p2;
        const f32x4 c0 = *(const f32x4*)(RC + t * 32 + 8 * jq), c1 = *(const f32x4*)(RC + t * 32 + 8 * jq + 4);
        const f32x4 s0 = *(const f32x4*)(RS + t * 32 + 8 * jq), s1 = *(const f32x4*)(RS + t * 32 + 8 * jq + 4);
        const float cs[8] = {c0.x, c0.y, c0.z, c0.w, c1.x, c1.y, c1.z, c1.w}, sn[8] = {s0.x, s0.y, s0.z, s0.w, s1.x, s1.y, s1.z, s1.w};
        const unsigned aw[4] = {a.x, a.y, a.z, a.w}, bw[4] = {b.x, b.y, b.z, b.w};
        unsigned o1[4], o2[4];
#pragma unroll
        for (int w = 0; w < 4; ++w) {
            const float x1l = bflo(aw[w]), x1h = bfhi(aw[w]), x2l = bflo(bw[w]), x2h = bfhi(bw[w]);
            o1[w] = pk2(x1l * cs[2 * w] - x2l * sn[2 * w], x1h * cs[2 * w + 1] - x2h * sn[2 * w + 1]);
            o2[w] = pk2(x2l * cs[2 * w] + x1l * sn[2 * w], x2h * cs[2 * w + 1] + x1h * sn[2 * w + 1]);
        }
        *(u32x4*)p1 = (u32x4){o1[0], o1[1], o1[2], o1[3]}; *(u32x4*)p2 = (u32x4){o2[0], o2[1], o2[2], o2[3]};
    }
}

template <bool EMIT>
__device__ __forceinline__ void s5_pass(const Params& P, LAS unsigned char* buw, int g, int lane, int tbase, float ar, float ai, float& hr, float& hi,
                                        const bf16x8 (&bb)[4], const bf16x8 (&cm)[4], float dsk) {
    const bf16* Z = (const bf16*)(P.ws + OFF_Z);
    bf16* YB = (bf16*)(P.ws + OFF_YB);
    LAS float* BU = (LAS float*)buw;
    for (int ch = 0; ch < 32; ++ch) {
        const int t0 = tbase + 32 * ch;
        const bf16x8 ua = *(const bf16x8*)(Z + (size_t)(t0 + (lane & 31)) * INW + 3 * AW + 16 * g + 8 * (lane >> 5));
#pragma unroll
        for (int nt = 0; nt < 4; ++nt) {
            f32x16 acc;
#pragma unroll
            for (int i = 0; i < 16; ++i) acc[i] = 0.f;
            acc = __builtin_amdgcn_mfma_f32_32x32x16_bf16(ua, bb[nt], acc, 0, 0, 0);
#pragma unroll
            for (int r = 0; r < 16; ++r) {
                const int t = (r & 3) + 8 * (r >> 2) + 4 * (lane >> 5);
                BU[t * 128 + 32 * nt + (lane & 31)] = acc[r];
            }
        }
#pragma unroll 4
        for (int t = 0; t < 32; ++t) {
            const float br = BU[t * 128 + lane], bi = BU[t * 128 + 64 + lane];
            const float nr = ar * hr - ai * hi + br, ni = ar * hi + ai * hr + bi;
            hr = nr; hi = ni;
            if (EMIT) {
                LAS unsigned short* Hrow = (LAS unsigned short*)(buw + t * 512);
                const int c0 = (lane >> 3), c1 = 8 + (lane >> 3), sw = t & 15;
                Hrow[((c0 ^ sw) << 3) + (lane & 7)] = (unsigned short)f2bf(hr);
                Hrow[((c1 ^ sw) << 3) + (lane & 7)] = (unsigned short)f2bf(hi);
            }
        }
        if (EMIT) {
#pragma unroll
            for (int mt = 0; mt < 2; ++mt) {
                f32x4 acc = {0.f, 0.f, 0.f, 0.f};
                const int trow = 16 * mt + (lane & 15);
#pragma unroll
                for (int ks = 0; ks < 4; ++ks) {
                    const int cch = 4 * ks + (lane >> 4);
                    const bf16x8 ha = *(const LAS bf16x8*)(buw + trow * 512 + ((cch ^ (trow & 15)) << 4));
                    acc = mfma16(ha, cm[ks], acc);
                }
#pragma unroll
                for (int r = 0; r < 4; ++r) {
                    const int t = t0 + 16 * mt + 4 * (lane >> 4) + r;
                    const float u = bf2f(Z[(size_t)t * INW + 3 * AW + 16 * g + (lane & 15)]);
                    const float y = acc[r] + dsk * u;
                    YB[(size_t)t * AW + 16 * g + (lane & 15)] = (bf16)f2bf(gelu_exact(y));
                }
            }
        }
    }
}
__device__ __forceinline__ void s5_group(const Params& P, LAS unsigned char* lds, int g, int lane, int wave) {
    const float ar = ((const float*)(P.ws + OFF_AR))[g * SN + lane], ai = ((const float*)(P.ws + OFF_AI))[g * SN + lane];
    const bf16* BB = (const bf16*)(P.ws + OFF_BBAR) + (size_t)g * 128 * 16;
    const bf16* CM = (const bf16*)(P.ws + OFF_CMT) + (size_t)g * 16 * 128;
    bf16x8 bb[4], cm[4];
#pragma unroll
    for (int nt = 0; nt < 4; ++nt) bb[nt] = *(const bf16x8*)(BB + (32 * nt + (lane & 31)) * 16 + 8 * (lane >> 5));
#pragma unroll
    for (int ks = 0; ks < 4; ++ks) cm[ks] = *(const bf16x8*)(CM + (lane & 15) * 128 + 32 * ks + 8 * (lane >> 4));
    const float dsk = P.ssm_d[g * SP + (lane & 15)];
    LAS unsigned char* buw = lds + wave * 16384;
    LAS float* E = (LAS float*)(lds + 131072);
    float hr = 0.f, hi = 0.f;
    s5_pass<false>(P, buw, g, lane, wave * 1024, ar, ai, hr, hi, bb, cm, dsk);
    E[wave * 128 + lane] = hr; E[wave * 128 + 64 + lane] = hi;
    __syncthreads();
    float pr = ar, pi = ai;
#pragma unroll
    for (int i = 0; i < 10; ++i) { const float nr = pr * pr - pi * pi, ni = 2.f * pr * pi; pr = nr; pi = ni; }
    hr = 0.f; hi = 0.f;
    for (int v = 0; v < wave; ++v) {
        const float er = E[v * 128 + lane], ei = E[v * 128 + 64 + lane];
        const float nr = pr * hr - pi * hi + er, ni = pr * hi + pi * hr + ei;
        hr = nr; hi = ni;
    }
    s5_pass<true>(P, buw, g, lane, wave * 1024, ar, ai, hr, hi, bb, cm, dsk);
    __syncthreads();
}

constexpr int VT_STRIDE = 592, P_STRIDE = 336, VT_BYTES = 64 * VT_STRIDE, PW_BYTES = 16 * P_STRIDE;
__device__ __forceinline__ void attn_tile(const Params& P, LAS unsigned char* lds, int it, int tid, int lane, int wave) {
    const int pi = it >> 10, rem = it & 1023, h = rem >> 6, cb = rem & 63;
    const int d = (pi == 0) ? 1 : (pi == 1) ? 4 : 16, lognb = (pi == 0) ? 6 : (pi == 1) ? 4 : 2;
    const int r = cb >> lognb, n = cb & ((1 << lognb) - 1);
    const bf16* Z = (const bf16*)(P.ws + OFF_Z);
    LAS unsigned char* Vt = lds; LAS unsigned char* Pw = lds + VT_BYTES + wave * PW_BYTES;
    for (int e = tid; e < 64 * 16; e += NTHREADS) { const int dim = e >> 4, kk = e & 15; *(LAS unsigned*)(Vt + dim * VT_STRIDE + 512 + kk * 4) = 0u; }
    {
        const int key = tid >> 1, half = tid & 1;
        int cp = 128 * (n - 1) + key; cp = cp < 0 ? 0 : cp;
        const bf16* src = Z + (size_t)(cp * d + r) * INW + 2 * AW + h * HD + half * 32;
#pragma unroll
        for (int q = 0; q < 4; ++q) {
            const u32x4 v = *(const u32x4*)(src + 8 * q);
            const unsigned w[4] = {v.x, v.y, v.z, v.w};
#pragma unroll
            for (int e = 0; e < 4; ++e) {
                const int dim = half * 32 + 8 * q + 2 * e;
                *(LAS unsigned short*)(Vt + dim * VT_STRIDE + key * 2) = (unsigned short)(w[e] & 0xffffu);
                *(LAS unsigned short*)(Vt + (dim + 1) * VT_STRIDE + key * 2) = (unsigned short)(w[e] >> 16);
            }
        }
    }
    const int fr = lane & 15, fq = lane >> 4;
    const size_t tq_frag = (size_t)((128 * n + 16 * wave + fr) * d + r);
    bf16x8 qa[2];
#pragma unroll
    for (int ks = 0; ks < 2; ++ks) qa[ks] = *(const bf16x8*)(Z + tq_frag * INW + h * HD + 32 * ks + 8 * fq);
    f32x4 sc[9];
#pragma unroll
    for (int j = 0; j < 9; ++j) {
        const int kj = 16 * (wave + j) + fr;
        int cp = 128 * (n - 1) + kj; cp = cp < 0 ? 0 : cp;
        const bf16* kp = Z + (size_t)(cp * d + r) * INW + AW + h * HD + 8 * fq;
        f32x4 acc = {0.f, 0.f, 0.f, 0.f};
        acc = mfma16(qa[0], *(const bf16x8*)(kp), acc);
        acc = mfma16(qa[1], *(const bf16x8*)(kp + 32), acc);
        sc[j] = acc;
    }
    float mx[4] = {-3.0e38f, -3.0e38f, -3.0e38f, -3.0e38f};
#pragma unroll
    for (int j = 0; j < 9; ++j)
#pragma unroll
        for (int rr = 0; rr < 4; ++rr) {
            const int rel = 128 + 4 * fq + rr - 16 * j - fr;
            const int kj = 16 * (wave + j) + fr;
            const bool ok = (rel >= 0) && (rel <= 128) && (n > 0 || kj >= 128);
            const float s = ok ? sc[j][rr] * 0.125f : -1.0e30f;
            sc[j][rr] = s; mx[rr] = fmaxf(mx[rr], s);
        }
#pragma unroll
    for (int rr = 0; rr < 4; ++rr) {
#pragma unroll
        for (int o = 1; o < 16; o <<= 1) mx[rr] = fmaxf(mx[rr], __shfl_xor(mx[rr], o));
    }
    float ls[4] = {0.f, 0.f, 0.f, 0.f};
#pragma unroll
    for (int j = 0; j < 9; ++j)
#pragma unroll
        for (int rr = 0; rr < 4; ++rr) {
            const float p = __expf(sc[j][rr] - mx[rr]);
            ls[rr] += p;
            *(LAS unsigned short*)(Pw + (4 * fq + rr) * P_STRIDE + (16 * j + fr) * 2) = (unsigned short)f2bf(p);
        }
#pragma unroll
    for (int rr = 0; rr < 4; ++rr) {
#pragma unroll
        for (int o = 1; o < 16; o <<= 1) ls[rr] += __shfl_xor(ls[rr], o);
    }
    *(LAS u32x2*)(Pw + (lane >> 2) * P_STRIDE + 288 + 8 * (lane & 3)) = (u32x2){0u, 0u};
    __syncthreads();
    f32x4 oc[4];
#pragma unroll
    for (int i = 0; i < 4; ++i) oc[i] = (f32x4){0.f, 0.f, 0.f, 0.f};
#pragma unroll
    for (int ks = 0; ks < 5; ++ks) {
        const bf16x8 pa = *(const LAS bf16x8*)(Pw + fr * P_STRIDE + (32 * ks + 8 * fq) * 2);
#pragma unroll
        for (int nt = 0; nt < 4; ++nt) {
            const bf16x8 vb = *(const LAS bf16x8*)(Vt + (16 * nt + fr) * VT_STRIDE + (16 * wave + 32 * ks + 8 * fq) * 2);
            oc[nt] = mfma16(pa, vb, oc[nt]);
        }
    }
    bf16* OP = (bf16*)(P.ws + OFF_OP) + (size_t)pi * S * AW;
    float* LSE = (float*)(P.ws + OFF_LSE) + (size_t)pi * S * NH;
#pragma unroll
    for (int rr = 0; rr < 4; ++rr) {
        const size_t tq = (size_t)((128 * n + 16 * wave + 4 * fq + rr) * d + r);
        const float inv = 1.f / ls[rr];
#pragma unroll
        for (int nt = 0; nt < 4; ++nt) OP[tq * AW + h * HD + 16 * nt + fr] = (bf16)f2bf(oc[nt][rr] * inv);
        if (fr == 0) LSE[tq * NH + h] = mx[rr] + logf(ls[rr]);
    }
    __syncthreads();
}

__device__ __forceinline__ void combine_token(const Params& P, int t, int lane) {
    const bf16* OP = (const bf16*)(P.ws + OFF_OP); const float* LSE = (const float*)(P.ws + OFF_LSE);
    bf16* MIX = (bf16*)(P.ws + OFF_MIX);
    const int h = lane >> 2;
    float l0 = LSE[(size_t)(0 * S + t) * NH + h], l1 = LSE[(size_t)(1 * S + t) * NH + h], l2 = LSE[(size_t)(2 * S + t) * NH + h];
    const float m = fmaxf(l0, fmaxf(l1, l2));
    float w0 = __expf(l0 - m), w1 = __expf(l1 - m), w2 = __expf(l2 - m);
    const float inv = 1.f / (w0 + w1 + w2); w0 *= inv; w1 *= inv; w2 *= inv;
    float a[16]; float ss = 0.f;
    const size_t off = (size_t)t * AW + 16 * lane;
#pragma unroll
    for (int q = 0; q < 2; ++q) {
        const u32x4 v0 = *(const u32x4*)(OP + off + 8 * q), v1 = *(const u32x4*)(OP + (size_t)S * AW + off + 8 * q), v2 = *(const u32x4*)(OP + (size_t)2 * S * AW + off + 8 * q);
        const unsigned x0[4] = {v0.x, v0.y, v0.z, v0.w}, x1[4] = {v1.x, v1.y, v1.z, v1.w}, x2[4] = {v2.x, v2.y, v2.z, v2.w};
#pragma unroll
        for (int e = 0; e < 4; ++e) {
            const float lo = w0 * bflo(x0[e]) + w1 * bflo(x1[e]) + w2 * bflo(x2[e]);
            const float hi = w0 * bfhi(x0[e]) + w1 * bfhi(x1[e]) + w2 * bfhi(x2[e]);
            a[8 * q + 2 * e] = lo; a[8 * q + 2 * e + 1] = hi; ss += lo * lo + hi * hi;
        }
    }
    const float rs = 1.f / sqrtf(wave_sum(ss) * (1.f / AW) + LN_EPS);
#pragma unroll
    for (int q = 0; q < 2; ++q) {
        u32x4 o; o.x = pk2(a[8 * q] * rs, a[8 * q + 1] * rs); o.y = pk2(a[8 * q + 2] * rs, a[8 * q + 3] * rs);
        o.z = pk2(a[8 * q + 4] * rs, a[8 * q + 5] * rs); o.w = pk2(a[8 * q + 6] * rs, a[8 * q + 7] * rs);
        *(u32x4*)(MIX + (size_t)t * D + 16 * lane + 8 * q) = o;
    }
}
__device__ __forceinline__ void glu_strip(const Params& P, LAS unsigned char* lds, int strip, int lane, int wave) {
    const bf16* YB = (const bf16*)(P.ws + OFF_YB); const bf16* WG = (const bf16*)(P.ws + OFF_WGLU);
    bf16* MIX = (bf16*)(P.ws + OFF_MIX);
    LAS float* red = (LAS float*)lds;
    const int row0 = strip * 64, col0 = wave * 128, fr = lane & 15, fq = lane >> 4;
    f32x4 acc[4][8];
#pragma unroll
    for (int a = 0; a < 4; ++a)
#pragma unroll
        for (int b = 0; b < 8; ++b) acc[a][b] = (f32x4){0.f, 0.f, 0.f, 0.f};
    const bf16* ap = YB + (size_t)(row0 + fr) * AW + 8 * fq;
    const bf16* bp = WG + (size_t)(col0 + fr) * AW + 8 * fq;
    for (int k = 0; k < AW; k += 32) {
        bf16x8 a[4], b[8];
#pragma unroll
        for (int i = 0; i < 4; ++i) a[i] = *(const bf16x8*)(ap + (size_t)(16 * i) * AW + k);
#pragma unroll
        for (int i = 0; i < 8; ++i) b[i] = *(const bf16x8*)(bp + (size_t)(16 * i) * AW + k);
#pragma unroll
        for (int mi = 0; mi < 4; ++mi)
#pragma unroll
            for (int ni = 0; ni < 8; ++ni) acc[mi][ni] = mfma16(b[ni], a[mi], acc[mi][ni]);
    }
    float ssr[4];
#pragma unroll
    for (int mi = 0; mi < 4; ++mi) {
        float ss = 0.f;
        const int m = row0 + 16 * mi + fr;
#pragma unroll
        for (int ni = 0; ni < 8; ++ni) {
            const int nn = col0 + 16 * ni + 4 * fq;
            const u32x2 yv = *(const u32x2*)(YB + (size_t)m * AW + nn);
            const f32x4 bg = *(const f32x4*)(P.b_glu + nn);
            const float y4[4] = {bflo(yv.x), bfhi(yv.x), bflo(yv.y), bfhi(yv.y)};
            f32x4 o;
#pragma unroll
            for (int e = 0; e < 4; ++e) { const float gte = acc[mi][ni][e] + bg[e]; const float v = y4[e] / (1.f + __expf(-gte)); o[e] = v; ss += v * v; }
            acc[mi][ni] = o;
        }
        ss += __shfl_xor(ss, 16); ss += __shfl_xor(ss, 32);
        ssr[mi] = ss;
    }
    if (fq == 0) {
#pragma unroll
        for (int mi = 0; mi < 4; ++mi) red[wave * 64 + 16 * mi + fr] = ssr[mi];
    }
    __syncthreads();
#pragma unroll
    for (int mi = 0; mi < 4; ++mi) {
        float tot = 0.f;
#pragma unroll
        for (int w = 0; w < 8; ++w) tot += red[w * 64 + 16 * mi + fr];
        const float rs = 1.f / sqrtf(tot * (1.f / AW) + LN_EPS);
        const int m = row0 + 16 * mi + fr;
#pragma unroll
        for (int ni = 0; ni < 8; ++ni) {
            const int nn = col0 + 16 * ni + 4 * fq;
            u32x2 w; w.x = pk2(acc[mi][ni][0] * rs, acc[mi][ni][1] * rs); w.y = pk2(acc[mi][ni][2] * rs, acc[mi][ni][3] * rs);
            *(u32x2*)(MIX + (size_t)m * D + AW + nn) = w;
        }
    }
    __syncthreads();
}

__device__ __forceinline__ void phase_ln_mid(const Params& P, int lane, int gw, int NGW) {
    const float* MOD = (const float*)(P.ws + OFF_MOD); const float* PRE = (const float*)(P.ws + OFF_PRE);
    bf16* HB = (bf16*)(P.ws + OFF_HB);
    for (int m = gw; m < S; m += NGW) {
        const f32x4* xr = (const f32x4*)(PRE + (size_t)m * D) + lane;
        f32x4 v[8]; float s = 0.f;
#pragma unroll
        for (int j = 0; j < 8; ++j) { v[j] = xr[64 * j]; s += (v[j].x + v[j].y) + (v[j].z + v[j].w); }
        float mean = wave_sum(s) * (1.f / D); float s2 = 0.f;
#pragma unroll
        for (int j = 0; j < 8; ++j) { v[j] = v[j] - mean; s2 += (v[j].x * v[j].x + v[j].y * v[j].y) + (v[j].z * v[j].z + v[j].w * v[j].w); }
        float rstd = 1.f / sqrtf(wave_sum(s2) * (1.f / D) + LN_EPS);
        f32x4* o4 = (f32x4*)(P.out + (size_t)m * D) + lane;
        s = 0.f;
#pragma unroll
        for (int j = 0; j < 8; ++j) {
            const int c0 = 4 * (lane + 64 * j);
            const f32x4 g = *(const f32x4*)(P.ln1_g + c0), b = *(const f32x4*)(P.ln1_b + c0);
            v[j] = v[j] * rstd * g + b; o4[64 * j] = v[j];
            s += (v[j].x + v[j].y) + (v[j].z + v[j].w);
        }
        mean = wave_sum(s) * (1.f / D); s2 = 0.f;
#pragma unroll
        for (int j = 0; j < 8; ++j) { v[j] = v[j] - mean; s2 += (v[j].x * v[j].x + v[j].y * v[j].y) + (v[j].z * v[j].z + v[j].w * v[j].w); }
        rstd = 1.f / sqrtf(wave_sum(s2) * (1.f / D) + LN_EPS);
        u32x2* o8 = (u32x2*)(HB + (size_t)m * D) + lane;
#pragma unroll
        for (int j = 0; j < 8; ++j) {
            const int c0 = 4 * (lane + 64 * j);
            const f32x4 sh = *(const f32x4*)(MOD + 3 * D + c0), sc = *(const f32x4*)(MOD + 4 * D + c0);
            const f32x4 y = v[j] * rstd * (sc + 1.f) + sh;
            u32x2 w; w.x = pk2(y.x, y.y); w.y = pk2(y.z, y.w);
            o8[64 * j] = w;
        }
    }
}

__device__ __forceinline__ void phase_scores(const Params& P, int lane, int gw, int NGW) {
    const bf16* QP = (const bf16*)(P.ws + OFF_Z); const bf16* SK = (const bf16*)(P.ws + OFF_SKB);
    float* SC = (float*)(P.ws + OFF_PRE);
    const int fr = lane & 15, fq = lane >> 4;
    for (int it = gw; it < (S / 16) * PH * 2; it += NGW) {
        const int i = it & 1, h = (it >> 1) & 7, tb = it >> 4;
        const bf16* ap = QP + (size_t)(tb * 16 + fr) * D + h * 256 + i * 128 + 8 * fq;
        bf16x8 a[4];
#pragma unroll
        for (int ks = 0; ks < 4; ++ks) a[ks] = *(const bf16x8*)(ap + 32 * ks);
#pragma unroll
        for (int nt = 0; nt < 8; ++nt) {
            const bf16* bp = SK + (size_t)(i * 128 + 16 * nt + fr) * 128 + 8 * fq;
            f32x4 acc = {0.f, 0.f, 0.f, 0.f};
#pragma unroll
            for (int ks = 0; ks < 4; ++ks) acc = mfma16(*(const bf16x8*)(bp + 32 * ks), a[ks], acc);
            *(f32x4*)(SC + (size_t)(tb * 16 + fr) * D + h * 256 + i * 128 + 16 * nt + 4 * fq) = acc;
        }
    }
}

__device__ __forceinline__ unsigned sortable(float f) { const unsigned u = __float_as_uint(f); return u ^ ((u >> 31) ? 0xffffffffu : 0x80000000u); }
__device__ __forceinline__ float unsortable(unsigned k) { const unsigned u = (k & 0x80000000u) ? (k ^ 0x80000000u) : ~k; return __uint_as_float(u); }
__device__ __forceinline__ void phase_topk(const Params& P, int tid, int bid, int G) {
    const float* SC = (const float*)(P.ws + OFF_PRE);
    int* IDX = (int*)(P.ws + OFF_IDX); float* GATE = (float*)(P.ws + OFF_GATE);
    for (int it = bid * NTHREADS + tid; it < S * PH; it += G * NTHREADS) {
        const float* sp = SC + (size_t)it * 256;
        unsigned L[2][16];
#pragma unroll
        for (int i = 0; i < 2; ++i) {
#pragma unroll
            for (int a = 0; a < 16; ++a) L[i][a] = 0u;
            for (int k4 = 0; k4 < 32; ++k4) {
                const f32x4 v = *(const f32x4*)(sp + i * 128 + 4 * k4);
#pragma unroll
                for (int e = 0; e < 4; ++e) {
                    unsigned x = (sortable(v[e]) & 0xffffff80u) | (unsigned)(127 - (4 * k4 + e));
#pragma unroll
                    for (int a = 0; a < 16; ++a) { const unsigned hi = L[i][a] > x ? L[i][a] : x, lo = L[i][a] > x ? x : L[i][a]; L[i][a] = hi; x = lo; }
                }
            }
        }
        float sa[2][16]; int ia[2][16];
#pragma unroll
        for (int i = 0; i < 2; ++i)
#pragma unroll
            for (int a = 0; a < 16; ++a) { const int k = 127 - (int)(L[i][a] & 127u); ia[i][a] = k; sa[i][a] = sp[i * 128 + k]; }
        unsigned B[16];
#pragma unroll
        for (int a = 0; a < 16; ++a) B[a] = 0u;
#pragma unroll
        for (int a = 0; a < 16; ++a)
#pragma unroll
            for (int b = 0; b < 16; ++b)
                if ((a + 1) * (b + 1) <= 16) {
                    unsigned x = (sortable(sa[0][a] + sa[1][b]) & 0xffffff00u) | (unsigned)(255 - (a * 16 + b));
#pragma unroll
                    for (int q = 0; q < 16; ++q) { const unsigned hi = B[q] > x ? B[q] : x, lo = B[q] > x ? x : B[q]; B[q] = hi; x = lo; }
                }
        float gs[16]; float gm = -3.0e38f;
#pragma unroll
        for (int q = 0; q < 16; ++q) { gs[q] = unsortable(B[q] & 0xffffff00u); gm = fmaxf(gm, gs[q]); }
        float gsum = 0.f;
#pragma unroll
        for (int q = 0; q < 16; ++q) { gs[q] = __expf(gs[q] - gm); gsum += gs[q]; }
        const float ginv = 1.f / gsum;
#pragma unroll
        for (int q = 0; q < 16; ++q) {
            const int code = 255 - (int)(B[q] & 255u), a = code >> 4, b = code & 15;
            int i0 = ia[0][0], i1 = ia[1][0];
#pragma unroll
            for (int j = 1; j < 16; ++j) { i0 = (a == j) ? ia[0][j] : i0; i1 = (b == j) ? ia[1][j] : i1; }
            IDX[(size_t)it * 16 + q] = i0 * 128 + i1;
            GATE[(size_t)it * 16 + q] = gs[q] * ginv;
        }
    }
}

__device__ __forceinline__ float ub0(unsigned w) { return (float)(w & 0xffu); }
__device__ __forceinline__ float ub1(unsigned w) { return (float)((w >> 8) & 0xffu); }
__device__ __forceinline__ float ub2(unsigned w) { return (float)((w >> 16) & 0xffu); }
__device__ __forceinline__ float ub3(unsigned w) { return (float)(w >> 24); }
__device__ __forceinline__ void phase_experts(const Params& P, int lane, int gw, int NGW) {
    const bf16* HB = (const bf16*)(P.ws + OFF_HB); const unsigned char* EU = P.ws + OFF_EU; const unsigned char* EV = P.ws + OFF_EV;
    const float* SCU = (const float*)(P.ws + OFF_ESCU); const float* SCV = (const float*)(P.ws + OFF_ESCV);
    const int* IDX = (const int*)(P.ws + OFF_IDX); const float* GATE = (const float*)(P.ws + OFF_GATE);
    const float* MOD = (const float*)(P.ws + OFF_MOD);
    for (int t = gw; t < S; t += NGW) {
        float hf[32]; float hs = 0.f;
#pragma unroll
        for (int j = 0; j < 2; ++j)
#pragma unroll
            for (int q = 0; q < 2; ++q) {
                const u32x4 v = *(const u32x4*)(HB + (size_t)t * D + 16 * (lane + 64 * j) + 8 * q);
                float* h8 = hf + 16 * j + 8 * q;
                h8[0] = bflo(v.x); h8[1] = bfhi(v.x); h8[2] = bflo(v.y); h8[3] = bfhi(v.y);
                h8[4] = bflo(v.z); h8[5] = bfhi(v.z); h8[6] = bflo(v.w); h8[7] = bfhi(v.w);
            }
#pragma unroll
        for (int i = 0; i < 32; ++i) hs += hf[i];
        hs = wave_sum(hs) * 128.f;
        float y[32];
#pragma unroll
        for (int i = 0; i < 32; ++i) y[i] = 0.f;
        float ctot = 0.f;
        const int id0 = IDX[(size_t)t * 128 + lane], id1 = IDX[(size_t)t * 128 + 64 + lane];
        const float g0 = GATE[(size_t)t * 128 + lane], g1 = GATE[(size_t)t * 128 + 64 + lane];
        for (int k = 0; k < 128; k += 4) {
            int e[4]; float gt[4], su[4], sv[4];
#pragma unroll
            for (int q = 0; q < 4; ++q) {
                const int kk = k + q;
                e[q] = (kk < 64) ? __builtin_amdgcn_readlane(id0, kk & 63) : __builtin_amdgcn_readlane(id1, kk & 63);
                gt[q] = __uint_as_float((kk < 64) ? __builtin_amdgcn_readlane(__float_as_uint(g0), kk & 63) : __builtin_amdgcn_readlane(__float_as_uint(g1), kk & 63));
                su[q] = SCU[e[q]]; sv[q] = SCV[e[q]];
            }
            u32x4 uu[4][2], vv[4][2];
#pragma unroll
            for (int q = 0; q < 4; ++q)
#pragma unroll
                for (int j = 0; j < 2; ++j) {
                    uu[q][j] = *(const u32x4*)(EU + (size_t)e[q] * D + 16 * (lane + 64 * j));
                    vv[q][j] = *(const u32x4*)(EV + (size_t)e[q] * D + 16 * (lane + 64 * j));
                }
#pragma unroll
            for (int q = 0; q < 4; ++q) {
                float dt = 0.f;
#pragma unroll
                for (int j = 0; j < 2; ++j) {
                    const unsigned w[4] = {uu[q][j].x, uu[q][j].y, uu[q][j].z, uu[q][j].w};
#pragma unroll
                    for (int i = 0; i < 4; ++i) {
                        const float* h4 = hf + 16 * j + 4 * i;
                        dt += h4[0] * ub0(w[i]) + h4[1] * ub1(w[i]) + h4[2] * ub2(w[i]) + h4[3] * ub3(w[i]);
                    }
                }
                dt = (wave_sum(dt) - hs) * su[q];
                const float cv = gt[q] * gelu_exact(dt) * sv[q];
                ctot += cv;
#pragma unroll
                for (int j = 0; j < 2; ++j) {
                    const unsigned w[4] = {vv[q][j].x, vv[q][j].y, vv[q][j].z, vv[q][j].w};
#pragma unroll
                    for (int i = 0; i < 4; ++i) {
                        float* y4 = y + 16 * j + 4 * i;
                        y4[0] += cv * ub0(w[i]); y4[1] += cv * ub1(w[i]); y4[2] += cv * ub2(w[i]); y4[3] += cv * ub3(w[i]);
                    }
                }
            }
        }
        float* orow = P.out + (size_t)t * D;
        const float yoff = 128.f * ctot;
        float s = 0.f;
#pragma unroll
        for (int j = 0; j < 2; ++j) {
            const int c0 = 16 * (lane + 64 * j);
#pragma unroll
            for (int q = 0; q < 4; ++q) {
                const f32x4 xv = *(const f32x4*)(orow + c0 + 4 * q), g = *(const f32x4*)(MOD + 5 * D + c0 + 4 * q);
#pragma unroll
                for (int i = 0; i < 4; ++i) { const float v = DN_ALPHA * xv[i] + (1.f + g[i]) * (y[16 * j + 4 * q + i] - yoff); y[16 * j + 4 * q + i] = v; s += v; }
            }
        }
        const float mean = wave_sum(s) * (1.f / D); float s2 = 0.f;
#pragma unroll
        for (int i = 0; i < 32; ++i) { y[i] -= mean; s2 += y[i] * y[i]; }
        const float rstd = 1.f / sqrtf(wave_sum(s2) * (1.f / D) + LN_EPS);
#pragma unroll
        for (int j = 0; j < 2; ++j) {
            const int c0 = 16 * (lane + 64 * j);
#pragma unroll
            for (int q = 0; q < 4; ++q) {
                const f32x4 g = *(const f32x4*)(P.ln2_g + c0 + 4 * q), b = *(const f32x4*)(P.ln2_b + c0 + 4 * q);
                f32x4 o;
#pragma unroll
                for (int i = 0; i < 4; ++i) o[i] = y[16 * j + 4 * q + i] * rstd * g[i] + b[i];
                *(f32x4*)(orow + c0 + 4 * q) = o;
            }
        }
    }
}

__global__ void __launch_bounds__(NTHREADS) hymba_fwd(Params P) {
    extern __shared__ __attribute__((aligned(16))) unsigned char lds_raw[];
    LAS unsigned char* lds = (LAS unsigned char*)lds_raw;
    const int tid = threadIdx.x, lane = tid & 63, wave = __builtin_amdgcn_readfirstlane(tid >> 6);
    const int bid = blockIdx.x, G = gridDim.x, gw = bid * NWAVES + wave, NGW = G * NWAVES;
    unsigned char* ws = P.ws;
    volatile LAS unsigned* bst = (volatile LAS unsigned*)(lds + LDS_BYTES - 16);
    if (tid < 4) bst[tid] = 0u;
    __syncthreads();
    const XcdBarrier gbar = xcd_barrier_post((unsigned*)(ws + OFF_BAR), bst);
#define GRID_SYNC() xcd_barrier(gbar)

    phase_prep(P, lds, tid, lane, wave, bid, G);
    GRID_SYNC();
    phase_ln1(P, lane, gw, NGW);
    GRID_SYNC();
    { EpiStoreBf16 e{(bf16*)(ws + OFF_Z), INW}; gemm_simple((const bf16*)(ws + OFF_HB), D, (const bf16*)(ws + OFF_WIN), D, S, INW, D, e, lane, wave, bid, G); }
    GRID_SYNC();
    phase_rope(P, tid, bid, G);
    GRID_SYNC();
    {
        for (int g = bid; g < SG; g += G) s5_group(P, lds, g, lane, wave);
        for (int it = bid; it < 3 * NH * 64; it += G) attn_tile(P, lds, it, tid, lane, wave);
    }
    GRID_SYNC();
    {
        const int nGlu = (G >= 256) ? 128 : (G / 2 > 0 ? G / 2 : 1);
        if (bid < nGlu) { for (int st = bid; st < S / 64; st += nGlu) glu_strip(P, lds, st, lane, wave); }
        if (G == 1 || bid >= nGlu) {
            const int cb = (G == 1) ? 0 : bid - nGlu, cn = (G == 1) ? 1 : G - nGlu;
            for (int t = cb * NWAVES + wave; t < S; t += cn * NWAVES) combine_token(P, t, lane);
        }
    }
    GRID_SYNC();
    { EpiOutProj e{P.x, (const float*)(ws + OFF_MOD) + 2 * D, (float*)(ws + OFF_PRE)}; gemm_simple((const bf16*)(ws + OFF_MIX), D, (const bf16*)(ws + OFF_WOUT), D, S, D, D, e, lane, wave, bid, G); }
    GRID_SYNC();
    phase_ln_mid(P, lane, gw, NGW);
    GRID_SYNC();
    { EpiStoreBf16 e{(bf16*)(ws + OFF_Z), D}; gemm_simple((const bf16*)(ws + OFF_HB), D, (const bf16*)(ws + OFF_WQP), D, S, D, D, e, lane, wave, bid, G); }
    GRID_SYNC();
    phase_scores(P, lane, gw, NGW);
    GRID_SYNC();
    phase_topk(P, tid, bid, G);
    GRID_SYNC();
    phase_experts(P, lane, gw, NGW);
}

extern "C" void kernel_launch(void* const* d_in, const int* in_sizes, int n_in, void* d_out, int out_size, void* d_ws, size_t ws_size, hipStream_t stream) {
    static int grid_blocks = 0;
    if (grid_blocks == 0) {
        if (n_in != 27 || ws_size < WS_NEED) { fprintf(stderr, "kernel_launch: unexpected n_in %d or ws_size %zu (need %zu)\n", n_in, ws_size, (size_t)WS_NEED); grid_blocks = -1; return; }
        int dev = 0, cus = 0, per_cu = 0;
        (void)hipGetDevice(&dev);
        (void)hipDeviceGetAttribute(&cus, hipDeviceAttributeMultiprocessorCount, dev);
        (void)hipFuncSetAttribute((const void*)hymba_fwd, hipFuncAttributeMaxDynamicSharedMemorySize, LDS_BYTES);
        if (hipOccupancyMaxActiveBlocksPerMultiprocessor(&per_cu, (const void*)hymba_fwd, NTHREADS, LDS_BYTES) != hipSuccess || per_cu < 1) per_cu = 1;
        grid_blocks = cus;
        fprintf(stderr, "kernel_launch: cus %d per_cu %d grid %d\n", cus, per_cu, grid_blocks);
    }
    if (grid_blocks < 0) return;
    Params p{};
    p.x = (const float*)d_in[0]; p.c = (const float*)d_in[1]; p.pos = (const int*)d_in[2]; p.w_ada = (const float*)d_in[3]; p.b_ada = (const float*)d_in[4];
    p.w_in = (const float*)d_in[5]; p.lam_re = (const float*)d_in[6]; p.lam_im = (const float*)d_in[7]; p.log_dt = (const float*)d_in[8];
    p.b_re = (const float*)d_in[9]; p.b_im = (const float*)d_in[10]; p.c_re = (const float*)d_in[11]; p.c_im = (const float*)d_in[12]; p.ssm_d = (const float*)d_in[13];
    p.w_glu = (const float*)d_in[14]; p.b_glu = (const float*)d_in[15]; p.g_attn = (const float*)d_in[16]; p.g_ssm = (const float*)d_in[17]; p.w_out = (const float*)d_in[18];
    p.ln1_g = (const float*)d_in[19]; p.ln1_b = (const float*)d_in[20]; p.w_qp = (const float*)d_in[21]; p.sub_keys = (const float*)d_in[22];
    p.expert_u = (const float*)d_in[23]; p.expert_v = (const float*)d_in[24]; p.ln2_g = (const float*)d_in[25]; p.ln2_b = (const float*)d_in[26];
    p.out = (float*)d_out; p.ws = (unsigned char*)d_ws;
    if (hipMemsetAsync((unsigned char*)d_ws + OFF_BAR, 0, BAR_ZERO_BYTES, stream) != hipSuccess) { fprintf(stderr, "kernel_launch: memset of barrier words failed\n"); return; }
    hipLaunchKernelGGL(hymba_fwd, dim3(grid_blocks), dim3(NTHREADS), LDS_BYTES, stream, p);
    const hipError_t e = hipPeekAtLastError();
    if (e != hipSuccess) fprintf(stderr, "launch failed: %s (grid %d)\n", hipGetErrorString(e), grid_blocks);
}
```

```cpp
#include <hip/hip_runtime.h>
#include <cstdio>
#include <cstdint>

typedef unsigned short bf16;
typedef short bf16x8 __attribute__((ext_vector_type(8)));
typedef float f32x4 __attribute__((ext_vector_type(4)));
typedef float f32x16 __attribute__((ext_vector_type(16)));
typedef unsigned u32x4 __attribute__((ext_vector_type(4)));
typedef unsigned u32x2 __attribute__((ext_vector_type(2)));
#define LAS __attribute__((address_space(3)))

constexpr int S = 8192, D = 2048, AW = 1024, NH = 16, HD = 64, INW = 4096;
constexpr int SG = 64, SP = 16, SN = 64;
constexpr int PH = 8, NE = 16384;
constexpr float LN_EPS = 1e-5f;
constexpr float DN_ALPHA = 1.189207115002721f;
constexpr int NTHREADS = 512, NWAVES = 8;
constexpr int LDS_BYTES = 143360;

constexpr size_t MiB = 1u << 20, KiB = 1u << 10;
constexpr size_t OFF_MOD = 0, OFF_AR = 64 * KiB, OFF_AI = 80 * KiB, OFF_BBAR = 128 * KiB, OFF_CMT = 384 * KiB, OFF_SKB = 640 * KiB;
constexpr size_t OFF_SSY = 13 * MiB;
constexpr size_t OFF_BAR = 704 * KiB, BAR_ZERO_BYTES = 16 * KiB;
constexpr size_t OFF_ROPEC = 1 * MiB, OFF_ROPES = 2 * MiB, OFF_LSE = 3 * MiB, OFF_IDX = 5 * MiB, OFF_GATE = 9 * MiB;
constexpr size_t OFF_WIN = 16 * MiB, OFF_WGLU = 32 * MiB, OFF_WOUT = 34 * MiB, OFF_WQP = 42 * MiB;
constexpr size_t OFF_EU = 64 * MiB, OFF_EV = 96 * MiB, OFF_ESCU = 128 * MiB, OFF_ESCV = 129 * MiB, OFF_HB = 192 * MiB, OFF_Z = 224 * MiB, OFF_OP = 288 * MiB;
constexpr size_t OFF_MIX = 336 * MiB, OFF_YB = 368 * MiB, OFF_PRE = 384 * MiB, WS_NEED = 448 * MiB;

struct Params {
    const float* x; const float* c; const int* pos; const float* w_ada; const float* b_ada; const float* w_in;
    const float* lam_re; const float* lam_im; const float* log_dt; const float* b_re; const float* b_im; const float* c_re; const float* c_im;
    const float* ssm_d; const float* w_glu; const float* b_glu; const float* g_attn; const float* g_ssm; const float* w_out;
    const float* ln1_g; const float* ln1_b; const float* w_qp; const float* sub_keys; const float* expert_u; const float* expert_v;
    const float* ln2_g; const float* ln2_b;
    float* out; unsigned char* ws;
};

__device__ __forceinline__ unsigned f2bf(float f) { unsigned u = __float_as_uint(f); return (u + 0x7fffu + ((u >> 16) & 1u)) >> 16; }
__device__ __forceinline__ unsigned pk2(float lo, float hi) { return f2bf(lo) | (f2bf(hi) << 16); }
__device__ __forceinline__ float bf2f(unsigned b) { return __uint_as_float(b << 16); }
__device__ __forceinline__ float bflo(unsigned w) { return __uint_as_float(w << 16); }
__device__ __forceinline__ float bfhi(unsigned w) { return __uint_as_float(w & 0xffff0000u); }
__device__ __forceinline__ float wave_sum(float v) {
#pragma unroll
    for (int o = 1; o < 64; o <<= 1) v += __shfl_xor(v, o);
    return v;
}
__device__ __forceinline__ float gelu_exact(float x) { return 0.5f * x * (1.f + erff(x * 0.70710678118654752f)); }
__device__ __forceinline__ f32x4 mfma16(bf16x8 a, bf16x8 b, f32x4 c) { return __builtin_amdgcn_mfma_f32_16x16x32_bf16(a, b, c, 0, 0, 0); }

__device__ __forceinline__ void sincos_d(double x, double& s, double& c) {
    const double TWO_OVER_PI = 0.63661977236758134308, PIO2_HI = 1.57079632679489655800, PIO2_LO = 6.12323399573676603587e-17;
    const double q = __builtin_rint(x * TWO_OVER_PI);
    double r = __builtin_fma(-q, PIO2_HI, x); r = __builtin_fma(-q, PIO2_LO, r);
    const double r2 = r * r;
    double sp = -1.0 / 1307674368000.0;
    sp = sp * r2 + 1.0 / 6227020800.0; sp = sp * r2 - 1.0 / 39916800.0; sp = sp * r2 + 1.0 / 362880.0; sp = sp * r2 - 1.0 / 5040.0;
    sp = sp * r2 + 1.0 / 120.0; sp = sp * r2 - 1.0 / 6.0; sp = sp * r2 + 1.0;
    const double sr = sp * r;
    double cp = 1.0 / 20922789888000.0;
    cp = cp * r2 - 1.0 / 87178291200.0; cp = cp * r2 + 1.0 / 479001600.0; cp = cp * r2 - 1.0 / 3628800.0; cp = cp * r2 + 1.0 / 40320.0;
    cp = cp * r2 - 1.0 / 720.0; cp = cp * r2 + 1.0 / 24.0; cp = cp * r2 - 0.5; cp = cp * r2 + 1.0;
    const long long qi = (long long)q; const int m = (int)(qi & 3);
    s = (m == 0) ? sr : (m == 1) ? cp : (m == 2) ? -sr : -cp;
    c = (m == 0) ? cp : (m == 1) ? -sr : (m == 2) ? -cp : sr;
}

#define XB_TMO      128
#define XB_XCNT(j)  (256  + 64 * (j))
#define XB_XSUB(j)  (1280 + 64 * (j))
#define XB_XGEN(j)  (2304 + 64 * (j))
#define XB_TOP      3328
#define XB_TOPGEN   3392
#define XCD_BAR_WORDS 3456
#define XB_SPIN_CAP (1u << 18)
__device__ __forceinline__ unsigned xb_ld(unsigned* p)              { return __hip_atomic_load(p, __ATOMIC_RELAXED, __HIP_MEMORY_SCOPE_AGENT); }
__device__ __forceinline__ unsigned xb_add(unsigned* p, unsigned v) { return __hip_atomic_fetch_add(p, v, __ATOMIC_RELAXED, __HIP_MEMORY_SCOPE_AGENT); }
__device__ __forceinline__ unsigned xb_xcc_id() { return (unsigned)__builtin_amdgcn_s_getreg((3 << 11) | 20) & 0xFu; }
#define XB_SPIN(cond, bar) do { unsigned _sp = 0; while (cond) { __builtin_amdgcn_s_sleep(1); \
    if ((++_sp & 255u) == 0u) { if (xb_ld(&(bar)[XB_TMO])) break; if (_sp > XB_SPIN_CAP) { atomicAdd(&(bar)[XB_TMO], 1u); break; } } } } while (0)
struct XcdBarrier { unsigned* bar; unsigned x; volatile LAS unsigned* st; };
__device__ __forceinline__ XcdBarrier xcd_barrier_post(unsigned* bar, volatile LAS unsigned* st) {
    XcdBarrier b; b.bar = bar; b.x = xb_xcc_id(); b.st = st;
    if (threadIdx.x == 0) (void)xb_add(&bar[XB_XCNT(b.x)], 1u);
    return b;
}
__device__ __forceinline__ void xcd_barrier_complete(unsigned* bar, unsigned x, unsigned& nloc, unsigned& nx) {
    const unsigned G = gridDim.x * gridDim.y * gridDim.z;
    unsigned sum, cnt, mine, sp = 0u;
    for (;;) {
        sum = 0u; cnt = 0u; mine = 0u;
#pragma unroll
        for (unsigned j = 0; j < 16; ++j) { const unsigned c = xb_ld(&bar[XB_XCNT(j)]); sum += c; cnt += (c > 0u) ? 1u : 0u; mine = (j == x) ? c : mine; }
        if (sum == G) break;
        __builtin_amdgcn_s_sleep(1);
        if ((++sp & 255u) == 0u) { if (xb_ld(&bar[XB_TMO])) break; if (sp > XB_SPIN_CAP) { atomicAdd(&bar[XB_TMO], 1u); break; } }
    }
    nloc = mine > 0u ? mine : 1u; nx = cnt > 0u ? cnt : 1u;
}
__device__ __forceinline__ void xcd_barrier(const XcdBarrier& b) {
    asm volatile("s_waitcnt vmcnt(0)" ::: "memory");
    __syncthreads();
    if (threadIdx.x == 0) {
        unsigned* bar = b.bar;
        __builtin_amdgcn_s_waitcnt(0);
        unsigned nloc = b.st[0], nx = b.st[1];
        if (nloc == 0u) { xcd_barrier_complete(bar, b.x, nloc, nx); b.st[0] = nloc; b.st[1] = nx; }
        const unsigned old = xb_add(&bar[XB_XSUB(b.x)], 1u);
        const unsigned gen = old / nloc;
        if (old + 1u == (gen + 1u) * nloc) {
            __builtin_amdgcn_fence(__ATOMIC_RELEASE, "agent");
            asm volatile("s_waitcnt vmcnt(0)" ::: "memory");
            const unsigned og = xb_add(&bar[XB_TOP], 1u);
            const unsigned tg = og / nx;
            if (og + 1u == (tg + 1u) * nx) xb_add(&bar[XB_TOPGEN], 1u);
            else XB_SPIN(xb_ld(&bar[XB_TOPGEN]) == tg, bar);
            __builtin_amdgcn_fence(__ATOMIC_ACQUIRE, "agent");
            xb_add(&bar[XB_XGEN(b.x)], 1u);
            asm volatile("s_waitcnt vmcnt(0)" ::: "memory");
        } else {
            XB_SPIN(xb_ld(&bar[XB_XGEN(b.x)]) == gen, bar);
            __builtin_amdgcn_fence(__ATOMIC_ACQUIRE, "agent");
            asm volatile("s_waitcnt vmcnt(0)" ::: "memory");
        }
    }
    __syncthreads();
}

template <int MODE>
__device__ __forceinline__ void transpose_item(const float* W, int K, int N, bf16* WT, const float* ksc0, const float* ksc1, int ksplit, LAS float* scr, int item, int lane) {
    const int nblk = N / 32, kb = item / nblk, nb = item % nblk, k0 = 64 * kb, n0 = 32 * nb;
#pragma unroll 8
    for (int i = 0; i < 32; ++i) {
        const int kk = 2 * i + (lane >> 5);
        const int nc = n0 + (lane & 31);
        const int sc_ = (MODE == 1 && nc < 2 * AW) ? ((nc & ~63) + ((nc & 63) >> 1) + 32 * (nc & 1)) : nc;
        float v = W[(size_t)(k0 + kk) * N + sc_];
        if (MODE == 1 && nc < AW) v *= 0.125f;
        if (ksc0) { const int kg = k0 + kk; v *= (kg < ksplit) ? ksc0[kg] : ksc1[kg - ksplit]; }
        scr[kk * 33 + (lane & 31)] = v;
    }
    const int cc = lane & 7;
#pragma unroll
    for (int j = 0; j < 4; ++j) {
        const int n = (lane >> 3) + 8 * j; const LAS float* s = scr + (8 * cc) * 33 + n;
        u32x4 o; o.x = pk2(s[0 * 33], s[1 * 33]); o.y = pk2(s[2 * 33], s[3 * 33]); o.z = pk2(s[4 * 33], s[5 * 33]); o.w = pk2(s[6 * 33], s[7 * 33]);
        *(u32x4*)(WT + (size_t)(n0 + n) * K + k0 + 8 * cc) = o;
    }
}

__device__ __forceinline__ void phase_prep(const Params& P, LAS unsigned char* lds, int tid, int lane, int wave, int bid, int G) {
    unsigned char* ws = P.ws;
    {
        LAS float* red = (LAS float*)lds;
        float* MOD = (float*)(ws + OFF_MOD);
        for (int it = bid; it < 192; it += G) {
            const int col = it * 64 + lane, r0 = wave * 256;
            float acc = 0.f;
#pragma unroll 8
            for (int i = 0; i < 256; ++i) {
                const float cv = P.c[r0 + i];
                const float sl = cv / (1.f + expf(-cv));
                acc += sl * P.w_ada[(size_t)(r0 + i) * (6 * D) + col];
            }
            red[wave * 64 + lane] = acc;
            __syncthreads();
            if (wave == 0) {
                float s = P.b_ada[col];
#pragma unroll
                for (int w = 0; w < 8; ++w) s += red[w * 64 + lane];
                MOD[col] = s;
            }
            __syncthreads();
        }
    }
    __syncthreads();
    const int gw = bid * NWAVES + wave, NGW = G * NWAVES;
    LAS float* scr = (LAS float*)(lds + wave * 8704);
    constexpr int I_WIN = (D / 64) * (INW / 32), I_GLU = (AW / 64) * (AW / 32), I_OUT = (D / 64) * (D / 32), I_QP = (D / 64) * (D / 32);
    constexpr int I_EXP = 2 * NE, I_SK = 64, I_ROPE = S * 32 / 64, I_S5 = SG;
    constexpr int NITEMS = I_WIN + I_GLU + I_OUT + I_QP + I_EXP + I_SK + I_ROPE + I_S5;
    for (int it = gw; it < NITEMS; it += NGW) {
        int r = it;
        if (r < I_WIN) { transpose_item<1>(P.w_in, D, INW, (bf16*)(ws + OFF_WIN), nullptr, nullptr, 0, scr, r, lane); continue; } r -= I_WIN;
        if (r < I_GLU) { transpose_item<0>(P.w_glu, AW, AW, (bf16*)(ws + OFF_WGLU), nullptr, nullptr, 0, scr, r, lane); continue; } r -= I_GLU;
        if (r < I_OUT) { transpose_item<0>(P.w_out, D, D, (bf16*)(ws + OFF_WOUT), P.g_attn, P.g_ssm, AW, scr, r, lane); continue; } r -= I_OUT;
        if (r < I_QP) { transpose_item<0>(P.w_qp, D, D, (bf16*)(ws + OFF_WQP), nullptr, nullptr, 0, scr, r, lane); continue; } r -= I_QP;
        if (r < I_EXP) {
            const bool isu = r < NE; const int er = isu ? r : r - NE;
            const float* src = (isu ? P.expert_u : P.expert_v) + (size_t)er * D;
            unsigned char* dst = ws + (isu ? OFF_EU : OFF_EV) + (size_t)er * D;
            f32x4 a[4], b[4]; float m = 0.f;
#pragma unroll
            for (int j = 0; j < 4; ++j) {
                const int e0 = 8 * (lane + 64 * j);
                a[j] = *(const f32x4*)(src + e0); b[j] = *(const f32x4*)(src + e0 + 4);
#pragma unroll
                for (int i = 0; i < 4; ++i) m = fmaxf(m, fmaxf(fabsf(a[j][i]), fabsf(b[j][i])));
            }
#pragma unroll
            for (int o = 1; o < 64; o <<= 1) m = fmaxf(m, __shfl_xor(m, o));
            const float inv = m > 0.f ? 127.f / m : 0.f;
#pragma unroll
            for (int j = 0; j < 4; ++j) {
                unsigned w0 = 0u, w1 = 0u;
#pragma unroll
                for (int i = 0; i < 4; ++i) {
                    w0 |= (unsigned)((int)rintf(a[j][i] * inv) + 128) << (8 * i);
                    w1 |= (unsigned)((int)rintf(b[j][i] * inv) + 128) << (8 * i);
                }
                *(u32x2*)(dst + 8 * (lane + 64 * j)) = (u32x2){w0, w1};
            }
            if (lane == 0) ((float*)(ws + (isu ? OFF_ESCU : OFF_ESCV)))[er] = m * (1.f / 127.f);
            continue;
        } r -= I_EXP;
        if (r < I_SK) {
            const int e0 = r * 512 + lane * 8;
            const f32x4 a = *(const f32x4*)(P.sub_keys + e0), b = *(const f32x4*)(P.sub_keys + e0 + 4);
            u32x4 o; o.x = pk2(a.x, a.y); o.y = pk2(a.z, a.w); o.z = pk2(b.x, b.y); o.w = pk2(b.z, b.w);
            *(u32x4*)((bf16*)(ws + OFF_SKB) + e0) = o;
            continue;
        } r -= I_SK;
        if (r < I_ROPE) {
            const int e = r * 64 + lane, s = e >> 5, j = e & 31;
            const double RJ = 0.74989420933245582730;
            double f = 1.0;
            for (int q = 0; q < j; ++q) f *= RJ;
            const double ang = (double)P.pos[s] * f;
            double sn, cs; sincos_d(ang, sn, cs);
            ((float*)(ws + OFF_ROPEC))[e] = (float)cs; ((float*)(ws + OFF_ROPES))[e] = (float)sn;
            continue;
        } r -= I_ROPE;
        {
            const int g = r, n = lane;
            const double dt = exp((double)P.log_dt[g]);
            const double lr = (double)P.lam_re[g * SN + n], li = (double)P.lam_im[g * SN + n];
            const double mag = exp(lr * dt);
            double sn, cs; sincos_d(li * dt, sn, cs);
            const double ar = mag * cs, ai = mag * sn;
            const double den = lr * lr + li * li;
            const double cr = ((ar - 1.0) * lr + ai * li) / den, ci = (ai * lr - (ar - 1.0) * li) / den;
            ((float*)(ws + OFF_AR))[g * SN + n] = (float)ar; ((float*)(ws + OFF_AI))[g * SN + n] = (float)ai;
            bf16* BB = (bf16*)(ws + OFF_BBAR) + (size_t)g * 128 * 16;
            for (int p = 0; p < SP; ++p) {
                const double br = (double)P.b_re[(g * SN + n) * SP + p], bi = (double)P.b_im[(g * SN + n) * SP + p];
                BB[n * 16 + p] = (bf16)f2bf((float)(cr * br - ci * bi));
                BB[(64 + n) * 16 + p] = (bf16)f2bf((float)(cr * bi + ci * br));
            }
            bf16* CM = (bf16*)(ws + OFF_CMT) + (size_t)g * 16 * 128;
            for (int p = 0; p < SP; ++p) {
                CM[p * 128 + n] = (bf16)f2bf(P.c_re[(g * SP + p) * SN + n]);
                CM[p * 128 + 64 + n] = (bf16)f2bf(-P.c_im[(g * SP + p) * SN + n]);
            }
        }
    }
}

__device__ __forceinline__ void phase_ln1(const Params& P, int lane, int gw, int NGW) {
    const float* MOD = (const float*)(P.ws + OFF_MOD);
    bf16* HB = (bf16*)(P.ws + OFF_HB);
    for (int m = gw; m < S; m += NGW) {
        const f32x4* xr = (const f32x4*)(P.x + (size_t)m * D) + lane;
        f32x4 v[8]; float s = 0.f;
#pragma unroll
        for (int j = 0; j < 8; ++j) { v[j] = xr[64 * j]; s += (v[j].x + v[j].y) + (v[j].z + v[j].w); }
        const float mean = wave_sum(s) * (1.f / D); float s2 = 0.f;
#pragma unroll
        for (int j = 0; j < 8; ++j) { v[j] = v[j] - mean; s2 += (v[j].x * v[j].x + v[j].y * v[j].y) + (v[j].z * v[j].z + v[j].w * v[j].w); }
        const float rstd = 1.f / sqrtf(wave_sum(s2) * (1.f / D) + LN_EPS);
        u32x2* o8 = (u32x2*)(HB + (size_t)m * D) + lane;
#pragma unroll
        for (int j = 0; j < 8; ++j) {
            const int c0 = 4 * (lane + 64 * j);
            const f32x4 sh = *(const f32x4*)(MOD + c0), sc = *(const f32x4*)(MOD + D + c0);
            const f32x4 y = v[j] * rstd * (sc + 1.f) + sh;
            u32x2 w; w.x = pk2(y.x, y.y); w.y = pk2(y.z, y.w);
            o8[64 * j] = w;
        }
    }
}

namespace pg8 {
#define PG8_LAS __attribute__((address_space(3)))
typedef unsigned short bf16_t;
typedef short bf16x8 __attribute__((ext_vector_type(8)));
typedef float f32x4 __attribute__((ext_vector_type(4)));
typedef unsigned u32x4 __attribute__((ext_vector_type(4)));
constexpr int BM = 256, BK = 64, HALF = 128, HTB = HALF * BK * 2  , STAGE_BYTES = 8 * HTB, NXCD = 8, WGM = 8;

__host__ __device__ __forceinline__ int lds_byte(int r, int c) { const int st = (r >> 4) * 2 + (c >> 5), rr = r & 15, cc = c & 31, ob = rr * 64 + cc * 2; return st * 1024 + (ob ^ (((ob >> 9) & 1) << 5)); }
__host__ __device__ __forceinline__ void stage_rc(int b, int& R, int& C) { const int st = b / 1024, sb = b % 1024, swz = sb ^ (((sb >> 9) & 1) << 5); R = (st >> 1) * 16 + swz / 64; C = (st & 1) * 32 + (swz % 64) / 2; }
__host__ __device__ __forceinline__ int perm32(int rho) { const int n = rho >> 4, i = rho & 15; return 8 * (i >> 2) + 4 * n + (i & 3); }

struct Unit { int pm, pn, kh; };
struct Gemm { const bf16_t* A; const bf16_t* Bt; int M, N, K, ld; };

struct StaticOrder {
    int nM, nN, nwg, G, c;
    __host__ __device__ void init(int M, int N, int G_, int c_) { nM = M / BM; nN = N / BM; nwg = nM * nN; G = G_; c = c_; }
    __host__ __device__ bool next(int i, Unit& u) const {
        const long L = (long)i * G + c; if (L >= nwg) return false;
        int wgid = (int)L; { const int q = nwg / NXCD, r = nwg % NXCD, xcd = wgid % NXCD, off = wgid / NXCD; wgid = (xcd < r ? xcd * (q + 1) : r * (q + 1) + (xcd - r) * q) + off; }
        const int nig = WGM * nN, gid = wgid / nig, fm = gid * WGM, gsz = (nM - fm) < WGM ? (nM - fm) : WGM;
        u.pm = fm + ((wgid % nig) % gsz); u.pn = (wgid % nig) / gsz; u.kh = 0; return true;
    }
    __device__ __forceinline__ void a_ready(const Unit&) const {}
    __device__ __forceinline__ void done(const Unit&) const {}
};

template <class Epi, class Sched, bool ALIGN_EPI = false, bool SP2 = false>
__device__ __forceinline__ void gemm_phase(PG8_LAS unsigned char* lds, const Gemm g, const Sched& S, const Epi& E) {
    const int tid = threadIdx.x, wid = __builtin_amdgcn_readfirstlane(tid >> 6), lane = tid & 63, wr = wid >> 2, wc = wid & 3, fr = lane & 15, fq = lane >> 4;
    const int K = g.K, nt = K / BK, LD = g.ld;
    unsigned voffA[2], voffB[2];
#pragma unroll
    for (int i = 0; i < 2; ++i) { int R, C; stage_rc(tid * 16 + i * 8192, R, C); const int Rb = Epi::PERM ? ((R & ~31) + perm32(R & 31)) : R;
        voffA[i] = (unsigned)(R * LD + C) * 2u; voffB[i] = (unsigned)(Rb * LD + C) * 2u; }
    const size_t kstep = (size_t)(BK * 2);
    const size_t hstep = (size_t)HALF * LD * 2; const size_t khstep = (size_t)K * 2;
    const size_t tstep = 2 * hstep;
    const unsigned ldsw = (unsigned)wid * 1024u;
    const int aoff = lds_byte(wr * 64 + fr, fq * 8), boff = lds_byte(wc * 32 + fr, fq * 8);
#define PG8_SA(b, h) (((b) * 2 + (h)) * HTB)
#define PG8_SB(b, h) ((4 + (b) * 2 + (h)) * HTB)
#define PG8_STAGE(bufoff, gbase, voff) do { _Pragma("unroll") for (int _i = 0; _i < 2; ++_i) \
        __builtin_amdgcn_global_load_lds((const unsigned*)((const char*)(gbase) + (voff)[_i]), (PG8_LAS unsigned*)(lds + (bufoff) + ldsw + _i * 8192), 16, 0, 0); } while (0)
#define PG8_LDA(dst, b, h) do { _Pragma("unroll") for (int m = 0; m < 4; ++m) _Pragma("unroll") for (int k = 0; k < 2; ++k) dst[m][k] = *(const PG8_LAS bf16x8*)(lds + PG8_SA(b, h) + aoff + m * 2048 + k * 1024); } while (0)
#define PG8_LDB(dst, b, h) do { _Pragma("unroll") for (int n = 0; n < 2; ++n) _Pragma("unroll") for (int k = 0; k < 2; ++k) dst[n][k] = *(const PG8_LAS bf16x8*)(lds + PG8_SB(b, h) + boff + n * 2048 + k * 1024); } while (0)
#define PG8_MMA(ai, bj, At, Bt) do { __builtin_amdgcn_s_setprio(1); _Pragma("unroll") for (int m = 0; m < 4; ++m) _Pragma("unroll") for (int n = 0; n < 2; ++n) _Pragma("unroll") for (int k = 0; k < 2; ++k) \
        acc[ai][bj][m][n] = __builtin_amdgcn_mfma_f32_16x16x32_bf16(Bt[n][k], At[m][k], acc[ai][bj][m][n], 0, 0, 0); __builtin_amdgcn_s_setprio(0); } while (0)
#define PG8_WAIT_V(n) asm volatile("s_waitcnt vmcnt(" #n ")" ::: "memory")
#define PG8_WAIT_L(n) asm volatile("s_waitcnt lgkmcnt(" #n ")" ::: "memory")
#define PG8_BAR __builtin_amdgcn_s_barrier()
#define PG8_SCHED __builtin_amdgcn_sched_barrier(0)
    Unit cur, nxt; int ui = 0;
    if (!S.next(0, cur)) return;
    f32x4 acc[2][2][4][2];
#pragma unroll
    for (int a = 0; a < 2; ++a)
#pragma unroll
        for (int b = 0; b < 2; ++b)
#pragma unroll
            for (int m = 0; m < 4; ++m)
#pragma unroll
                for (int n = 0; n < 2; ++n) acc[a][b][m][n] = (f32x4){0.f, 0.f, 0.f, 0.f};
    bf16x8 At[4][2], B0[2][2], B1[2][2];
    const char* cA = (const char*)g.A + (size_t)cur.pm * tstep + (size_t)cur.kh * khstep; const char* cB = (const char*)g.Bt + (size_t)cur.pn * tstep + (size_t)cur.kh * khstep;
    S.a_ready(cur);
    if constexpr (SP2) {
        PG8_STAGE(PG8_SB(0, 0), cB, voffB); PG8_STAGE(PG8_SB(0, 1), cB + hstep, voffB); PG8_STAGE(PG8_SA(0, 0), cA, voffA); PG8_STAGE(PG8_SA(0, 1), cA + hstep, voffA);
        if (wr == 1) PG8_BAR;
        PG8_WAIT_V(2); PG8_BAR;
        PG8_STAGE(PG8_SB(1, 0), cB + kstep, voffB); PG8_STAGE(PG8_SA(1, 0), cA + kstep, voffA); PG8_STAGE(PG8_SB(1, 1), cB + hstep + kstep, voffB);
        PG8_WAIT_V(6); PG8_BAR;
    } else {
        PG8_STAGE(PG8_SB(0, 0), cB, voffB); PG8_STAGE(PG8_SA(0, 0), cA, voffA); PG8_STAGE(PG8_SB(0, 1), cB + hstep, voffB); PG8_STAGE(PG8_SA(0, 1), cA + hstep, voffA);
        if (wr == 1) PG8_BAR;
        PG8_WAIT_V(4); PG8_BAR;
        PG8_STAGE(PG8_SB(1, 0), cB + kstep, voffB); PG8_STAGE(PG8_SA(1, 0), cA + kstep, voffA); PG8_STAGE(PG8_SB(1, 1), cB + hstep + kstep, voffB);
        PG8_WAIT_V(6); PG8_BAR;
    }
    for (;;) {
        const bool has_next = S.next(ui + 1, nxt);
        const char* nA = has_next ? (const char*)g.A + (size_t)nxt.pm * tstep + (size_t)nxt.kh * khstep : cA; const char* nB = has_next ? (const char*)g.Bt + (size_t)nxt.pn * tstep + (size_t)nxt.kh * khstep : cB;
        for (int t = 0; t < nt; t += 2) {
            const bool last = (t == nt - 2);
            const char* a1 = cA + (size_t)(t + 1) * kstep;
            const char* a2 = last ? nA : cA + (size_t)(t + 2) * kstep; const char* b2 = last ? nB : cB + (size_t)(t + 2) * kstep;
            const char* a3 = a2 + kstep; const char* b3 = b2 + kstep;
            if (last && has_next) S.a_ready(nxt);
            if constexpr (SP2) {
            PG8_LDB(B0, 0, 0); PG8_LDB(B1, 0, 1); PG8_SCHED; PG8_LDA(At, 0, 0); PG8_STAGE(PG8_SA(1, 1), a1 + hstep, voffA);
            PG8_WAIT_V(8); PG8_WAIT_L(0); PG8_BAR; PG8_MMA(0, 0, At, B0); PG8_MMA(0, 1, At, B1); PG8_BAR; PG8_SCHED;
            PG8_LDA(At, 0, 1); PG8_STAGE(PG8_SB(0, 0), b2, voffB); PG8_STAGE(PG8_SB(0, 1), b2 + hstep, voffB); PG8_STAGE(PG8_SA(0, 0), a2, voffA);
            PG8_WAIT_V(8); PG8_WAIT_L(0); PG8_BAR; PG8_MMA(1, 0, At, B0); PG8_MMA(1, 1, At, B1); PG8_BAR; PG8_SCHED;
            PG8_LDB(B0, 1, 0); PG8_LDB(B1, 1, 1); PG8_SCHED; PG8_LDA(At, 1, 0); PG8_STAGE(PG8_SA(0, 1), a2 + hstep, voffA);
            PG8_WAIT_V(8); PG8_WAIT_L(0); PG8_BAR; PG8_MMA(0, 0, At, B0); PG8_MMA(0, 1, At, B1); PG8_BAR; PG8_SCHED;
            PG8_LDA(At, 1, 1); PG8_STAGE(PG8_SB(1, 0), b3, voffB); PG8_STAGE(PG8_SB(1, 1), b3 + hstep, voffB); PG8_STAGE(PG8_SA(1, 0), a3, voffA);
            PG8_WAIT_V(8); PG8_WAIT_L(0); PG8_BAR; PG8_MMA(1, 0, At, B0); PG8_MMA(1, 1, At, B1); PG8_BAR; PG8_SCHED;
            } else {
            PG8_LDB(B0, 0, 0); PG8_SCHED; PG8_LDA(At, 0, 0); PG8_STAGE(PG8_SA(1, 1), a1 + hstep, voffA);
            PG8_WAIT_L(8); PG8_BAR; PG8_WAIT_L(0); PG8_MMA(0, 0, At, B0); PG8_BAR; PG8_SCHED;
            PG8_LDB(B1, 0, 1); PG8_STAGE(PG8_SB(0, 0), b2, voffB);
            PG8_BAR; PG8_WAIT_L(0); PG8_MMA(0, 1, At, B1); PG8_BAR;
            PG8_LDA(At, 0, 1); PG8_STAGE(PG8_SA(0, 0), a2, voffA);
            PG8_BAR; PG8_WAIT_L(0); PG8_MMA(1, 0, At, B0); PG8_BAR; PG8_SCHED;
            PG8_STAGE(PG8_SB(0, 1), b2 + hstep, voffB);
            PG8_WAIT_V(6); PG8_BAR; PG8_MMA(1, 1, At, B1); PG8_BAR;
            PG8_LDB(B0, 1, 0); PG8_SCHED; PG8_LDA(At, 1, 0); PG8_STAGE(PG8_SA(0, 1), a2 + hstep, voffA);
            PG8_WAIT_L(8); PG8_BAR; PG8_WAIT_L(0); PG8_MMA(0, 0, At, B0); PG8_BAR; PG8_SCHED;
            PG8_LDB(B1, 1, 1); PG8_STAGE(PG8_SB(1, 0), b3, voffB);
            PG8_BAR; PG8_WAIT_L(0); PG8_MMA(0, 1, At, B1); PG8_BAR;
            PG8_LDA(At, 1, 1); PG8_STAGE(PG8_SA(1, 0), a3, voffA);
            PG8_BAR; PG8_WAIT_L(0); PG8_MMA(1, 0, At, B0); PG8_BAR; PG8_SCHED;
            PG8_STAGE(PG8_SB(1, 1), b3 + hstep, voffB);
            PG8_WAIT_V(6); PG8_BAR; PG8_MMA(1, 1, At, B1); PG8_BAR;
            }
        }
        if constexpr (ALIGN_EPI) { if (wr == 0) PG8_BAR; }
        if constexpr (!Epi::AFTER_DRAIN) { E(acc, cur, wr, wc, fr, fq); S.done(cur); }
        if (!has_next) break;
        if (!E.keep(cur))
#pragma unroll
        for (int a = 0; a < 2; ++a)
#pragma unroll
            for (int b = 0; b < 2; ++b)
#pragma unroll
                for (int m = 0; m < 4; ++m)
#pragma unroll
                    for (int n = 0; n < 2; ++n) acc[a][b][m][n] = (f32x4){0.f, 0.f, 0.f, 0.f};
        cur = nxt; cA = nA; cB = nB; ++ui;
        if constexpr (ALIGN_EPI) { if (wr == 1) PG8_BAR; }
    }
    PG8_WAIT_V(0);
    if constexpr (!ALIGN_EPI) { if (wr == 0) PG8_BAR; }
    PG8_BAR;
    if constexpr (Epi::AFTER_DRAIN) { E.fused(acc, cur, wr, wc, fr, fq, lds, wid, lane); S.done(cur); }
#undef PG8_SA
#undef PG8_SB
#undef PG8_STAGE
#undef PG8_LDA
#undef PG8_LDB
#undef PG8_MMA
#undef PG8_WAIT_V
#undef PG8_WAIT_L
#undef PG8_BAR
#undef PG8_SCHED
}
}

#define ROT2(V, I, J, C, SN) do { const float a_ = V[I] * (C) - V[J] * (SN), b_ = V[J] * (C) + V[I] * (SN); V[I] = a_; V[J] = b_; } while (0)
struct EpiRope {
    static constexpr bool PERM = true, AFTER_DRAIN = false;
    bf16* Z; const float* RC; const float* RS;
    __device__ __forceinline__ bool keep(const pg8::Unit&) const { return false; }
    __device__ __forceinline__ void operator()(f32x4 (&acc)[2][2][4][2], const pg8::Unit& u, int wr, int wc, int fr, int fq) const {
        const int row0 = u.pm * 256 + wr * 64 + fr, colt = u.pn * 256 + wc * 32 + 8 * fq;
        const bool rope = u.pn < 8;
#pragma unroll
        for (int ai = 0; ai < 2; ++ai)
#pragma unroll
            for (int m = 0; m < 4; ++m) {
                const int r = row0 + ai * 128 + m * 16;
#pragma unroll
                for (int bj = 0; bj < 2; ++bj) {
                    const int c0 = colt + bj * 128;
                    f32x4 v0 = acc[ai][bj][m][0], v1 = acc[ai][bj][m][1];
                    if (rope) {
                        const int j0 = (c0 & 63) >> 1;
                        const f32x4 cs = *(const f32x4*)(RC + (size_t)r * 32 + j0), sn = *(const f32x4*)(RS + (size_t)r * 32 + j0);
                        ROT2(v0, 0, 1, cs[0], sn[0]); ROT2(v0, 2, 3, cs[1], sn[1]); ROT2(v1, 0, 1, cs[2], sn[2]); ROT2(v1, 2, 3, cs[3], sn[3]);
                    }
                    u32x4 w; w.x = pk2(v0[0], v0[1]); w.y = pk2(v0[2], v0[3]); w.z = pk2(v1[0], v1[1]); w.w = pk2(v1[2], v1[3]);
                    *(u32x4*)(Z + (size_t)r * INW + c0) = w;
                }
            }
    }
};
struct EpiPlain {
    static constexpr bool PERM = true, AFTER_DRAIN = false;
    bf16* O; int ldc;
    __device__ __forceinline__ bool keep(const pg8::Unit&) const { return false; }
    __device__ __forceinline__ void operator()(f32x4 (&acc)[2][2][4][2], const pg8::Unit& u, int wr, int wc, int fr, int fq) const {
        const int row0 = u.pm * 256 + wr * 64 + fr, colt = u.pn * 256 + wc * 32 + 8 * fq;
#pragma unroll
        for (int ai = 0; ai < 2; ++ai)
#pragma unroll
            for (int m = 0; m < 4; ++m) {
                const int r = row0 + ai * 128 + m * 16;
#pragma unroll
                for (int bj = 0; bj < 2; ++bj) {
                    const f32x4 v0 = acc[ai][bj][m][0], v1 = acc[ai][bj][m][1];
                    u32x4 w; w.x = pk2(v0[0], v0[1]); w.y = pk2(v0[2], v0[3]); w.z = pk2(v1[0], v1[1]); w.w = pk2(v1[2], v1[3]);
                    *(u32x4*)(O + (size_t)r * ldc + colt + bj * 128) = w;
                }
            }
    }
};
struct EpiGlu {
    static constexpr bool PERM = true, AFTER_DRAIN = false;
    const bf16* YB; const float* bglu; bf16* MIX; float* SSY;
    __device__ __forceinline__ bool keep(const pg8::Unit&) const { return false; }
    __device__ __forceinline__ void operator()(f32x4 (&acc)[2][2][4][2], const pg8::Unit& u, int wr, int wc, int fr, int fq) const {
        const int row0 = u.pm * 256 + wr * 64 + fr, colt = u.pn * 256 + wc * 32 + 8 * fq;
#pragma unroll
        for (int ai = 0; ai < 2; ++ai)
#pragma unroll
            for (int m = 0; m < 4; ++m) {
                const int r = row0 + ai * 128 + m * 16;
                float ss = 0.f;
#pragma unroll
                for (int bj = 0; bj < 2; ++bj) {
                    const int c0 = colt + bj * 128;
                    const u32x4 yv = *(const u32x4*)(YB + (size_t)r * AW + c0);
                    const f32x4 b0 = *(const f32x4*)(bglu + c0), b1 = *(const f32x4*)(bglu + c0 + 4);
                    const float y8[8] = {bflo(yv.x), bfhi(yv.x), bflo(yv.y), bfhi(yv.y), bflo(yv.z), bfhi(yv.z), bflo(yv.w), bfhi(yv.w)};
                    float o[8];
#pragma unroll
                    for (int e = 0; e < 4; ++e) {
                        o[e] = y8[e] / (1.f + __expf(-(acc[ai][bj][m][0][e] + b0[e])));
                        o[4 + e] = y8[4 + e] / (1.f + __expf(-(acc[ai][bj][m][1][e] + b1[e])));
                    }
#pragma unroll
                    for (int e = 0; e < 8; ++e) ss += o[e] * o[e];
                    u32x4 w; w.x = pk2(o[0], o[1]); w.y = pk2(o[2], o[3]); w.z = pk2(o[4], o[5]); w.w = pk2(o[6], o[7]);
                    *(u32x4*)(MIX + (size_t)r * D + AW + c0) = w;
                }
                ss += __shfl_xor(ss, 16); ss += __shfl_xor(ss, 32);
                if (fq == 0) SSY[(size_t)r * 16 + u.pn * 4 + wc] = ss;
            }
    }
};
struct EpiOutProj {
    static constexpr bool PERM = false, AFTER_DRAIN = false;
    const float* x; const float* gt1; float* pre; const float* SSY;
    __device__ __forceinline__ bool keep(const pg8::Unit& u) const { return u.kh == 1; }
    __device__ __forceinline__ void operator()(f32x4 (&acc)[2][2][4][2], const pg8::Unit& u, int wr, int wc, int fr, int fq) const {
        const int row0 = u.pm * 256 + wr * 64 + fr;
        if (u.kh == 1) {
#pragma unroll
            for (int ai = 0; ai < 2; ++ai)
#pragma unroll
                for (int m = 0; m < 4; ++m) {
                    const int r = row0 + ai * 128 + m * 16;
                    const f32x4 s0 = *(const f32x4*)(SSY + (size_t)r * 16), s1 = *(const f32x4*)(SSY + (size_t)r * 16 + 4), s2 = *(const f32x4*)(SSY + (size_t)r * 16 + 8), s3 = *(const f32x4*)(SSY + (size_t)r * 16 + 12);
                    const f32x4 st = (s0 + s1) + (s2 + s3);
                    const float ry = 1.f / sqrtf(((st[0] + st[1]) + (st[2] + st[3])) * (1.f / AW) + LN_EPS);
#pragma unroll
                    for (int bj = 0; bj < 2; ++bj)
#pragma unroll
                        for (int n = 0; n < 2; ++n) acc[ai][bj][m][n] = acc[ai][bj][m][n] * ry;
                }
        } else {
            const int col0 = u.pn * 256 + wc * 32 + 4 * fq;
#pragma unroll
            for (int ai = 0; ai < 2; ++ai)
#pragma unroll
                for (int m = 0; m < 4; ++m) {
                    const int r = row0 + ai * 128 + m * 16;
#pragma unroll
                    for (int bj = 0; bj < 2; ++bj)
#pragma unroll
                        for (int n = 0; n < 2; ++n) {
                            const int c = col0 + bj * 128 + n * 16;
                            const f32x4 xv = *(const f32x4*)(x + (size_t)r * D + c), g = *(const f32x4*)(gt1 + c);
                            *(f32x4*)(pre + (size_t)r * D + c) = xv * DN_ALPHA + (g + 1.f) * acc[ai][bj][m][n];
                        }
                }
        }
    }
};
struct SplitKOrder {
    pg8::StaticOrder b;
    __device__ bool next(int i, pg8::Unit& u) const { if (!b.next(i >> 1, u)) return false; u.kh = 1 - (i & 1); return true; }
    __device__ __forceinline__ void a_ready(const pg8::Unit&) const {}
    __device__ __forceinline__ void done(const pg8::Unit&) const {}
};

template <bool EMIT>
__device__ __forceinline__ void s5_pass(const Params& P, LAS unsigned char* buw, int g, int lane, int tbase, float ar, float ai, float& hr, float& hi,
                                        const bf16x8 (&bb)[4], const bf16x8 (&cm)[4], float dsk) {
    const bf16* Z = (const bf16*)(P.ws + OFF_Z);
    bf16* YB = (bf16*)(P.ws + OFF_YB);
    LAS float* BU = (LAS float*)buw;
    for (int ch = 0; ch < 32; ++ch) {
        const int t0 = tbase + 32 * ch;
        const bf16x8 ua = *(const bf16x8*)(Z + (size_t)(t0 + (lane & 31)) * INW + 3 * AW + 16 * g + 8 * (lane >> 5));
#pragma unroll
        for (int nt = 0; nt < 4; ++nt) {
            f32x16 acc;
#pragma unroll
            for (int i = 0; i < 16; ++i) acc[i] = 0.f;
            acc = __builtin_amdgcn_mfma_f32_32x32x16_bf16(ua, bb[nt], acc, 0, 0, 0);
#pragma unroll
            for (int r = 0; r < 16; ++r) {
                const int t = (r & 3) + 8 * (r >> 2) + 4 * (lane >> 5);
                BU[t * 128 + 32 * nt + (lane & 31)] = acc[r];
            }
        }
#pragma unroll 4
        for (int t = 0; t < 32; ++t) {
            const float br = BU[t * 128 + lane], bi = BU[t * 128 + 64 + lane];
            const float nr = ar * hr - ai * hi + br, ni = ar * hi + ai * hr + bi;
            hr = nr; hi = ni;
            if (EMIT) {
                LAS unsigned short* Hrow = (LAS unsigned short*)(buw + t * 512);
                const int c0 = (lane >> 3), c1 = 8 + (lane >> 3), sw = t & 15;
                Hrow[((c0 ^ sw) << 3) + (lane & 7)] = (unsigned short)f2bf(hr);
                Hrow[((c1 ^ sw) << 3) + (lane & 7)] = (unsigned short)f2bf(hi);
            }
        }
        if (EMIT) {
#pragma unroll
            for (int mt = 0; mt < 2; ++mt) {
                f32x4 acc = {0.f, 0.f, 0.f, 0.f};
                const int trow = 16 * mt + (lane & 15);
#pragma unroll
                for (int ks = 0; ks < 4; ++ks) {
                    const int cch = 4 * ks + (lane >> 4);
                    const bf16x8 ha = *(const LAS bf16x8*)(buw + trow * 512 + ((cch ^ (trow & 15)) << 4));
                    acc = mfma16(ha, cm[ks], acc);
                }
#pragma unroll
                for (int r = 0; r < 4; ++r) {
                    const int t = t0 + 16 * mt + 4 * (lane >> 4) + r;
                    const float u = bf2f(Z[(size_t)t * INW + 3 * AW + 16 * g + (lane & 15)]);
                    const float y = acc[r] + dsk * u;
                    YB[(size_t)t * AW + 16 * g + (lane & 15)] = (bf16)f2bf(gelu_exact(y));
                }
            }
        }
    }
}
__device__ __forceinline__ void s5_group(const Params& P, LAS unsigned char* lds, int g, int lane, int wave) {
    const float ar = ((const float*)(P.ws + OFF_AR))[g * SN + lane], ai = ((const float*)(P.ws + OFF_AI))[g * SN + lane];
    const bf16* BB = (const bf16*)(P.ws + OFF_BBAR) + (size_t)g * 128 * 16;
    const bf16* CM = (const bf16*)(P.ws + OFF_CMT) + (size_t)g * 16 * 128;
    bf16x8 bb[4], cm[4];
#pragma unroll
    for (int nt = 0; nt < 4; ++nt) bb[nt] = *(const bf16x8*)(BB + (32 * nt + (lane & 31)) * 16 + 8 * (lane >> 5));
#pragma unroll
    for (int ks = 0; ks < 4; ++ks) cm[ks] = *(const bf16x8*)(CM + (lane & 15) * 128 + 32 * ks + 8 * (lane >> 4));
    const float dsk = P.ssm_d[g * SP + (lane & 15)];
    LAS unsigned char* buw = lds + wave * 16384;
    LAS float* E = (LAS float*)(lds + 131072);
    float hr = 0.f, hi = 0.f;
    s5_pass<false>(P, buw, g, lane, wave * 1024, ar, ai, hr, hi, bb, cm, dsk);
    E[wave * 128 + lane] = hr; E[wave * 128 + 64 + lane] = hi;
    __syncthreads();
    float pr = ar, pi = ai;
#pragma unroll
    for (int i = 0; i < 10; ++i) { const float nr = pr * pr - pi * pi, ni = 2.f * pr * pi; pr = nr; pi = ni; }
    hr = 0.f; hi = 0.f;
    for (int v = 0; v < wave; ++v) {
        const float er = E[v * 128 + lane], ei = E[v * 128 + 64 + lane];
        const float nr = pr * hr - pi * hi + er, ni = pr * hi + pi * hr + ei;
        hr = nr; hi = ni;
    }
    s5_pass<true>(P, buw, g, lane, wave * 1024, ar, ai, hr, hi, bb, cm, dsk);
    __syncthreads();
}

constexpr int VT_STRIDE = 592, P_STRIDE = 336, VT_BYTES = 64 * VT_STRIDE, PW_BYTES = 16 * P_STRIDE;
__device__ __forceinline__ void attn_tile(const Params& P, LAS unsigned char* lds, int it, int tid, int lane, int wave) {
    const int pi = it >> 10, rem = it & 1023, h = rem >> 6, cb = rem & 63;
    const int d = (pi == 0) ? 1 : (pi == 1) ? 4 : 16, lognb = (pi == 0) ? 6 : (pi == 1) ? 4 : 2;
    const int r = cb >> lognb, n = cb & ((1 << lognb) - 1);
    const bf16* Z = (const bf16*)(P.ws + OFF_Z);
    LAS unsigned char* Vt = lds; LAS unsigned char* Pw = lds + VT_BYTES + wave * PW_BYTES;
    for (int e = tid; e < 64 * 16; e += NTHREADS) { const int dim = e >> 4, kk = e & 15; *(LAS unsigned*)(Vt + dim * VT_STRIDE + 512 + kk * 4) = 0u; }
    {
        const int key = tid >> 1, half = tid & 1;
        int cp = 128 * (n - 1) + key; cp = cp < 0 ? 0 : cp;
        const bf16* src = Z + (size_t)(cp * d + r) * INW + 2 * AW + h * HD + half * 32;
#pragma unroll
        for (int q = 0; q < 4; ++q) {
            const u32x4 v = *(const u32x4*)(src + 8 * q);
            const unsigned w[4] = {v.x, v.y, v.z, v.w};
#pragma unroll
            for (int e = 0; e < 4; ++e) {
                const int dim = half * 32 + 8 * q + 2 * e;
                *(LAS unsigned short*)(Vt + dim * VT_STRIDE + key * 2) = (unsigned short)(w[e] & 0xffffu);
                *(LAS unsigned short*)(Vt + (dim + 1) * VT_STRIDE + key * 2) = (unsigned short)(w[e] >> 16);
            }
        }
    }
    const int fr = lane & 15, fq = lane >> 4;
    const size_t tq_frag = (size_t)((128 * n + 16 * wave + fr) * d + r);
    bf16x8 qa[2];
#pragma unroll
    for (int ks = 0; ks < 2; ++ks) qa[ks] = *(const bf16x8*)(Z + tq_frag * INW + h * HD + 32 * ks + 8 * fq);
    f32x4 sc[9];
#pragma unroll
    for (int j = 0; j < 9; ++j) {
        const int kj = 16 * (wave + j) + fr;
        int cp = 128 * (n - 1) + kj; cp = cp < 0 ? 0 : cp;
        const bf16* kp = Z + (size_t)(cp * d + r) * INW + AW + h * HD + 8 * fq;
        f32x4 acc = {0.f, 0.f, 0.f, 0.f};
        acc = mfma16(qa[0], *(const bf16x8*)(kp), acc);
        acc = mfma16(qa[1], *(const bf16x8*)(kp + 32), acc);
        sc[j] = acc;
    }
    float mx[4] = {-3.0e38f, -3.0e38f, -3.0e38f, -3.0e38f};
#pragma unroll
    for (int j = 0; j < 9; ++j)
#pragma unroll
        for (int rr = 0; rr < 4; ++rr) {
            const int rel = 128 + 4 * fq + rr - 16 * j - fr;
            const int kj = 16 * (wave + j) + fr;
            const bool ok = (rel >= 0) && (rel <= 128) && (n > 0 || kj >= 128);
            const float s = ok ? sc[j][rr] : -1.0e30f;
            sc[j][rr] = s; mx[rr] = fmaxf(mx[rr], s);
        }
#pragma unroll
    for (int rr = 0; rr < 4; ++rr) {
#pragma unroll
        for (int o = 1; o < 16; o <<= 1) mx[rr] = fmaxf(mx[rr], __shfl_xor(mx[rr], o));
    }
    float ls[4] = {0.f, 0.f, 0.f, 0.f};
#pragma unroll
    for (int j = 0; j < 9; ++j)
#pragma unroll
        for (int rr = 0; rr < 4; ++rr) {
            const float p = __expf(sc[j][rr] - mx[rr]);
            ls[rr] += p;
            *(LAS unsigned short*)(Pw + (4 * fq + rr) * P_STRIDE + (16 * j + fr) * 2) = (unsigned short)f2bf(p);
        }
#pragma unroll
    for (int rr = 0; rr < 4; ++rr) {
#pragma unroll
        for (int o = 1; o < 16; o <<= 1) ls[rr] += __shfl_xor(ls[rr], o);
    }
    *(LAS u32x2*)(Pw + (lane >> 2) * P_STRIDE + 288 + 8 * (lane & 3)) = (u32x2){0u, 0u};
    __syncthreads();
    f32x4 oc[4];
#pragma unroll
    for (int i = 0; i < 4; ++i) oc[i] = (f32x4){0.f, 0.f, 0.f, 0.f};
#pragma unroll
    for (int ks = 0; ks < 5; ++ks) {
        const bf16x8 pa = *(const LAS bf16x8*)(Pw + fr * P_STRIDE + (32 * ks + 8 * fq) * 2);
#pragma unroll
        for (int nt = 0; nt < 4; ++nt) {
            const bf16x8 vb = *(const LAS bf16x8*)(Vt + (16 * nt + fr) * VT_STRIDE + (16 * wave + 32 * ks + 8 * fq) * 2);
            oc[nt] = mfma16(pa, vb, oc[nt]);
        }
    }
    bf16* OP = (bf16*)(P.ws + OFF_OP) + (size_t)pi * S * AW;
    float* LSE = (float*)(P.ws + OFF_LSE) + (size_t)pi * S * NH;
#pragma unroll
    for (int rr = 0; rr < 4; ++rr) {
        const size_t tq = (size_t)((128 * n + 16 * wave + 4 * fq + rr) * d + r);
        const float inv = 1.f / ls[rr];
#pragma unroll
        for (int nt = 0; nt < 4; ++nt) OP[tq * AW + h * HD + 16 * nt + fr] = (bf16)f2bf(oc[nt][rr] * inv);
        if (fr == 0) LSE[tq * NH + h] = mx[rr] + logf(ls[rr]);
    }
    __syncthreads();
}

__device__ __forceinline__ void combine_token(const Params& P, int t, int lane) {
    const bf16* OP = (const bf16*)(P.ws + OFF_OP); const float* LSE = (const float*)(P.ws + OFF_LSE);
    bf16* MIX = (bf16*)(P.ws + OFF_MIX);
    const int h = lane >> 2;
    float l0 = LSE[(size_t)(0 * S + t) * NH + h], l1 = LSE[(size_t)(1 * S + t) * NH + h], l2 = LSE[(size_t)(2 * S + t) * NH + h];
    const float m = fmaxf(l0, fmaxf(l1, l2));
    float w0 = __expf(l0 - m), w1 = __expf(l1 - m), w2 = __expf(l2 - m);
    const float inv = 1.f / (w0 + w1 + w2); w0 *= inv; w1 *= inv; w2 *= inv;
    float a[16]; float ss = 0.f;
    const size_t off = (size_t)t * AW + 16 * lane;
#pragma unroll
    for (int q = 0; q < 2; ++q) {
        const u32x4 v0 = *(const u32x4*)(OP + off + 8 * q), v1 = *(const u32x4*)(OP + (size_t)S * AW + off + 8 * q), v2 = *(const u32x4*)(OP + (size_t)2 * S * AW + off + 8 * q);
        const unsigned x0[4] = {v0.x, v0.y, v0.z, v0.w}, x1[4] = {v1.x, v1.y, v1.z, v1.w}, x2[4] = {v2.x, v2.y, v2.z, v2.w};
#pragma unroll
        for (int e = 0; e < 4; ++e) {
            const float lo = w0 * bflo(x0[e]) + w1 * bflo(x1[e]) + w2 * bflo(x2[e]);
            const float hi = w0 * bfhi(x0[e]) + w1 * bfhi(x1[e]) + w2 * bfhi(x2[e]);
            a[8 * q + 2 * e] = lo; a[8 * q + 2 * e + 1] = hi; ss += lo * lo + hi * hi;
        }
    }
    const float rs = 1.f / sqrtf(wave_sum(ss) * (1.f / AW) + LN_EPS);
#pragma unroll
    for (int q = 0; q < 2; ++q) {
        u32x4 o; o.x = pk2(a[8 * q] * rs, a[8 * q + 1] * rs); o.y = pk2(a[8 * q + 2] * rs, a[8 * q + 3] * rs);
        o.z = pk2(a[8 * q + 4] * rs, a[8 * q + 5] * rs); o.w = pk2(a[8 * q + 6] * rs, a[8 * q + 7] * rs);
        *(u32x4*)(MIX + (size_t)t * D + 16 * lane + 8 * q) = o;
    }
}
__device__ __forceinline__ void phase_ln_mid(const Params& P, int lane, int gw, int NGW) {
    const float* MOD = (const float*)(P.ws + OFF_MOD); const float* PRE = (const float*)(P.ws + OFF_PRE);
    bf16* HB = (bf16*)(P.ws + OFF_HB);
    for (int m = gw; m < S; m += NGW) {
        const f32x4* xr = (const f32x4*)(PRE + (size_t)m * D) + lane;
        f32x4 v[8]; float s = 0.f;
#pragma unroll
        for (int j = 0; j < 8; ++j) { v[j] = xr[64 * j]; s += (v[j].x + v[j].y) + (v[j].z + v[j].w); }
        float mean = wave_sum(s) * (1.f / D); float s2 = 0.f;
#pragma unroll
        for (int j = 0; j < 8; ++j) { v[j] = v[j] - mean; s2 += (v[j].x * v[j].x + v[j].y * v[j].y) + (v[j].z * v[j].z + v[j].w * v[j].w); }
        float rstd = 1.f / sqrtf(wave_sum(s2) * (1.f / D) + LN_EPS);
        f32x4* o4 = (f32x4*)(P.out + (size_t)m * D) + lane;
        s = 0.f;
#pragma unroll
        for (int j = 0; j < 8; ++j) {
            const int c0 = 4 * (lane + 64 * j);
            const f32x4 g = *(const f32x4*)(P.ln1_g + c0), b = *(const f32x4*)(P.ln1_b + c0);
            v[j] = v[j] * rstd * g + b; o4[64 * j] = v[j];
            s += (v[j].x + v[j].y) + (v[j].z + v[j].w);
        }
        mean = wave_sum(s) * (1.f / D); s2 = 0.f;
#pragma unroll
        for (int j = 0; j < 8; ++j) { v[j] = v[j] - mean; s2 += (v[j].x * v[j].x + v[j].y * v[j].y) + (v[j].z * v[j].z + v[j].w * v[j].w); }
        rstd = 1.f / sqrtf(wave_sum(s2) * (1.f / D) + LN_EPS);
        u32x2* o8 = (u32x2*)(HB + (size_t)m * D) + lane;
#pragma unroll
        for (int j = 0; j < 8; ++j) {
            const int c0 = 4 * (lane + 64 * j);
            const f32x4 sh = *(const f32x4*)(MOD + 3 * D + c0), sc = *(const f32x4*)(MOD + 4 * D + c0);
            const f32x4 y = v[j] * rstd * (sc + 1.f) + sh;
            u32x2 w; w.x = pk2(y.x, y.y); w.y = pk2(y.z, y.w);
            o8[64 * j] = w;
        }
    }
}

__device__ __forceinline__ void phase_scores(const Params& P, int lane, int gw, int NGW) {
    const bf16* QP = (const bf16*)(P.ws + OFF_Z); const bf16* SK = (const bf16*)(P.ws + OFF_SKB);
    float* SC = (float*)(P.ws + OFF_PRE);
    const int fr = lane & 15, fq = lane >> 4;
    for (int it = gw; it < (S / 16) * PH * 2; it += NGW) {
        const int i = it & 1, h = (it >> 1) & 7, tb = it >> 4;
        const bf16* ap = QP + (size_t)(tb * 16 + fr) * D + h * 256 + i * 128 + 8 * fq;
        bf16x8 a[4];
#pragma unroll
        for (int ks = 0; ks < 4; ++ks) a[ks] = *(const bf16x8*)(ap + 32 * ks);
#pragma unroll
        for (int nt = 0; nt < 8; ++nt) {
            const bf16* bp = SK + (size_t)(i * 128 + 16 * nt + fr) * 128 + 8 * fq;
            f32x4 acc = {0.f, 0.f, 0.f, 0.f};
#pragma unroll
            for (int ks = 0; ks < 4; ++ks) acc = mfma16(*(const bf16x8*)(bp + 32 * ks), a[ks], acc);
            *(f32x4*)(SC + (size_t)(tb * 16 + fr) * D + h * 256 + i * 128 + 16 * nt + 4 * fq) = acc;
        }
    }
}

__device__ __forceinline__ unsigned sortable(float f) { const unsigned u = __float_as_uint(f); return u ^ ((u >> 31) ? 0xffffffffu : 0x80000000u); }
__device__ __forceinline__ float unsortable(unsigned k) { const unsigned u = (k & 0x80000000u) ? (k ^ 0x80000000u) : ~k; return __uint_as_float(u); }
__device__ __forceinline__ void phase_topk(const Params& P, int tid, int bid, int G) {
    const float* SC = (const float*)(P.ws + OFF_PRE);
    int* IDX = (int*)(P.ws + OFF_IDX); float* GATE = (float*)(P.ws + OFF_GATE);
    for (int it = bid * NTHREADS + tid; it < S * PH; it += G * NTHREADS) {
        const float* sp = SC + (size_t)it * 256;
        unsigned L[2][16];
#pragma unroll
        for (int i = 0; i < 2; ++i) {
#pragma unroll
            for (int a = 0; a < 16; ++a) L[i][a] = 0u;
            for (int k4 = 0; k4 < 32; ++k4) {
                const f32x4 v = *(const f32x4*)(sp + i * 128 + 4 * k4);
#pragma unroll
                for (int e = 0; e < 4; ++e) {
                    unsigned x = (sortable(v[e]) & 0xffffff80u) | (unsigned)(127 - (4 * k4 + e));
#pragma unroll
                    for (int a = 0; a < 16; ++a) { const unsigned hi = L[i][a] > x ? L[i][a] : x, lo = L[i][a] > x ? x : L[i][a]; L[i][a] = hi; x = lo; }
                }
            }
        }
        float sa[2][16]; int ia[2][16];
#pragma unroll
        for (int i = 0; i < 2; ++i)
#pragma unroll
            for (int a = 0; a < 16; ++a) { const int k = 127 - (int)(L[i][a] & 127u); ia[i][a] = k; sa[i][a] = sp[i * 128 + k]; }
        unsigned B[16];
#pragma unroll
        for (int a = 0; a < 16; ++a) B[a] = 0u;
#pragma unroll
        for (int a = 0; a < 16; ++a)
#pragma unroll
            for (int b = 0; b < 16; ++b)
                if ((a + 1) * (b + 1) <= 16) {
                    unsigned x = (sortable(sa[0][a] + sa[1][b]) & 0xffffff00u) | (unsigned)(255 - (a * 16 + b));
#pragma unroll
                    for (int q = 0; q < 16; ++q) { const unsigned hi = B[q] > x ? B[q] : x, lo = B[q] > x ? x : B[q]; B[q] = hi; x = lo; }
                }
        float gs[16]; float gm = -3.0e38f;
#pragma unroll
        for (int q = 0; q < 16; ++q) { gs[q] = unsortable(B[q] & 0xffffff00u); gm = fmaxf(gm, gs[q]); }
        float gsum = 0.f;
#pragma unroll
        for (int q = 0; q < 16; ++q) { gs[q] = __expf(gs[q] - gm); gsum += gs[q]; }
        const float ginv = 1.f / gsum;
#pragma unroll
        for (int q = 0; q < 16; ++q) {
            const int code = 255 - (int)(B[q] & 255u), a = code >> 4, b = code & 15;
            int i0 = ia[0][0], i1 = ia[1][0];
#pragma unroll
            for (int j = 1; j < 16; ++j) { i0 = (a == j) ? ia[0][j] : i0; i1 = (b == j) ? ia[1][j] : i1; }
            IDX[(size_t)it * 16 + q] = i0 * 128 + i1;
            GATE[(size_t)it * 16 + q] = gs[q] * ginv;
        }
    }
}

__device__ __forceinline__ float ub0(unsigned w) { return (float)(w & 0xffu); }
__device__ __forceinline__ float ub1(unsigned w) { return (float)((w >> 8) & 0xffu); }
__device__ __forceinline__ float ub2(unsigned w) { return (float)((w >> 16) & 0xffu); }
__device__ __forceinline__ float ub3(unsigned w) { return (float)(w >> 24); }
__device__ __forceinline__ void phase_experts(const Params& P, int lane, int gw, int NGW) {
    const bf16* HB = (const bf16*)(P.ws + OFF_HB); const unsigned char* EU = P.ws + OFF_EU; const unsigned char* EV = P.ws + OFF_EV;
    const float* SCU = (const float*)(P.ws + OFF_ESCU); const float* SCV = (const float*)(P.ws + OFF_ESCV);
    const int* IDX = (const int*)(P.ws + OFF_IDX); const float* GATE = (const float*)(P.ws + OFF_GATE);
    const float* MOD = (const float*)(P.ws + OFF_MOD);
    for (int t = gw; t < S; t += NGW) {
        float hf[32]; float hs = 0.f;
#pragma unroll
        for (int j = 0; j < 2; ++j)
#pragma unroll
            for (int q = 0; q < 2; ++q) {
                const u32x4 v = *(const u32x4*)(HB + (size_t)t * D + 16 * (lane + 64 * j) + 8 * q);
                float* h8 = hf + 16 * j + 8 * q;
                h8[0] = bflo(v.x); h8[1] = bfhi(v.x); h8[2] = bflo(v.y); h8[3] = bfhi(v.y);
                h8[4] = bflo(v.z); h8[5] = bfhi(v.z); h8[6] = bflo(v.w); h8[7] = bfhi(v.w);
            }
#pragma unroll
        for (int i = 0; i < 32; ++i) hs += hf[i];
        hs = wave_sum(hs) * 128.f;
        float y[32];
#pragma unroll
        for (int i = 0; i < 32; ++i) y[i] = 0.f;
        float ctot = 0.f;
        const int id0 = IDX[(size_t)t * 128 + lane], id1 = IDX[(size_t)t * 128 + 64 + lane];
        const float g0 = GATE[(size_t)t * 128 + lane], g1 = GATE[(size_t)t * 128 + 64 + lane];
        for (int k = 0; k < 128; k += 4) {
            int e[4]; float gt[4], su[4], sv[4];
#pragma unroll
            for (int q = 0; q < 4; ++q) {
                const int kk = k + q;
                e[q] = (kk < 64) ? __builtin_amdgcn_readlane(id0, kk & 63) : __builtin_amdgcn_readlane(id1, kk & 63);
                gt[q] = __uint_as_float((kk < 64) ? __builtin_amdgcn_readlane(__float_as_uint(g0), kk & 63) : __builtin_amdgcn_readlane(__float_as_uint(g1), kk & 63));
                su[q] = SCU[e[q]]; sv[q] = SCV[e[q]];
            }
            u32x4 uu[4][2], vv[4][2];
#pragma unroll
            for (int q = 0; q < 4; ++q)
#pragma unroll
                for (int j = 0; j < 2; ++j) {
                    uu[q][j] = *(const u32x4*)(EU + (size_t)e[q] * D + 16 * (lane + 64 * j));
                    vv[q][j] = *(const u32x4*)(EV + (size_t)e[q] * D + 16 * (lane + 64 * j));
                }
#pragma unroll
            for (int q = 0; q < 4; ++q) {
                float dt = 0.f;
#pragma unroll
                for (int j = 0; j < 2; ++j) {
                    const unsigned w[4] = {uu[q][j].x, uu[q][j].y, uu[q][j].z, uu[q][j].w};
#pragma unroll
                    for (int i = 0; i < 4; ++i) {
                        const float* h4 = hf + 16 * j + 4 * i;
                        dt += h4[0] * ub0(w[i]) + h4[1] * ub1(w[i]) + h4[2] * ub2(w[i]) + h4[3] * ub3(w[i]);
                    }
                }
                dt = (wave_sum(dt) - hs) * su[q];
                const float cv = gt[q] * gelu_exact(dt) * sv[q];
                ctot += cv;
#pragma unroll
                for (int j = 0; j < 2; ++j) {
                    const unsigned w[4] = {vv[q][j].x, vv[q][j].y, vv[q][j].z, vv[q][j].w};
#pragma unroll
                    for (int i = 0; i < 4; ++i) {
                        float* y4 = y + 16 * j + 4 * i;
                        y4[0] += cv * ub0(w[i]); y4[1] += cv * ub1(w[i]); y4[2] += cv * ub2(w[i]); y4[3] += cv * ub3(w[i]);
                    }
                }
            }
        }
        float* orow = P.out + (size_t)t * D;
        const float yoff = 128.f * ctot;
        float s = 0.f;
#pragma unroll
        for (int j = 0; j < 2; ++j) {
            const int c0 = 16 * (lane + 64 * j);
#pragma unroll
            for (int q = 0; q < 4; ++q) {
                const f32x4 xv = *(const f32x4*)(orow + c0 + 4 * q), g = *(const f32x4*)(MOD + 5 * D + c0 + 4 * q);
#pragma unroll
                for (int i = 0; i < 4; ++i) { const float v = DN_ALPHA * xv[i] + (1.f + g[i]) * (y[16 * j + 4 * q + i] - yoff); y[16 * j + 4 * q + i] = v; s += v; }
            }
        }
        const float mean = wave_sum(s) * (1.f / D); float s2 = 0.f;
#pragma unroll
        for (int i = 0; i < 32; ++i) { y[i] -= mean; s2 += y[i] * y[i]; }
        const float rstd = 1.f / sqrtf(wave_sum(s2) * (1.f / D) + LN_EPS);
#pragma unroll
        for (int j = 0; j < 2; ++j) {
            const int c0 = 16 * (lane + 64 * j);
#pragma unroll
            for (int q = 0; q < 4; ++q) {
                const f32x4 g = *(const f32x4*)(P.ln2_g + c0 + 4 * q), b = *(const f32x4*)(P.ln2_b + c0 + 4 * q);
                f32x4 o;
#pragma unroll
                for (int i = 0; i < 4; ++i) o[i] = y[16 * j + 4 * q + i] * rstd * g[i] + b[i];
                *(f32x4*)(orow + c0 + 4 * q) = o;
            }
        }
    }
}

__global__ void __launch_bounds__(NTHREADS) hymba_fwd(Params P) {
    extern __shared__ __attribute__((aligned(16))) unsigned char lds_raw[];
    LAS unsigned char* lds = (LAS unsigned char*)lds_raw;
    const int tid = threadIdx.x, lane = tid & 63, wave = __builtin_amdgcn_readfirstlane(tid >> 6);
    const int bid = blockIdx.x, G = gridDim.x, gw = bid * NWAVES + wave, NGW = G * NWAVES;
    unsigned char* ws = P.ws;
    volatile LAS unsigned* bst = (volatile LAS unsigned*)(lds + LDS_BYTES - 16);
    if (tid < 4) bst[tid] = 0u;
    __syncthreads();
    const XcdBarrier gbar = xcd_barrier_post((unsigned*)(ws + OFF_BAR), bst);
#define GRID_SYNC() xcd_barrier(gbar)

    phase_prep(P, lds, tid, lane, wave, bid, G);
    GRID_SYNC();
    phase_ln1(P, lane, gw, NGW);
    GRID_SYNC();
    {
        pg8::Gemm g{(const bf16*)(ws + OFF_HB), (const bf16*)(ws + OFF_WIN), S, INW, D, D}; pg8::StaticOrder so; so.init(S, INW, G, bid);
        EpiRope e{(bf16*)(ws + OFF_Z), (const float*)(ws + OFF_ROPEC), (const float*)(ws + OFF_ROPES)};
        pg8::gemm_phase<EpiRope, pg8::StaticOrder, true, true>(lds, g, so, e);
    }
    GRID_SYNC();
    {
        for (int g = bid; g < SG; g += G) s5_group(P, lds, g, lane, wave);
        for (int it = bid; it < 3 * NH * 64; it += G) attn_tile(P, lds, it, tid, lane, wave);
    }
    GRID_SYNC();
    {
        pg8::Gemm g{(const bf16*)(ws + OFF_YB), (const bf16*)(ws + OFF_WGLU), S, AW, AW, AW}; pg8::StaticOrder so; so.init(S, AW, G, bid);
        EpiGlu e{(const bf16*)(ws + OFF_YB), P.b_glu, (bf16*)(ws + OFF_MIX), (float*)(ws + OFF_SSY)};
        pg8::gemm_phase<EpiGlu, pg8::StaticOrder, true, true>(lds, g, so, e);
        const int nGlu = (S / 256) * (AW / 256);
        if (G > nGlu) { if (bid >= nGlu) for (int t = (bid - nGlu) * NWAVES + wave; t < S; t += (G - nGlu) * NWAVES) combine_token(P, t, lane); }
        else for (int t = gw; t < S; t += NGW) combine_token(P, t, lane);
    }
    GRID_SYNC();
    {
        pg8::Gemm g{(const bf16*)(ws + OFF_MIX), (const bf16*)(ws + OFF_WOUT), S, D, AW, D}; SplitKOrder so; so.b.init(S, D, G, bid);
        EpiOutProj e{P.x, (const float*)(ws + OFF_MOD) + 2 * D, (float*)(ws + OFF_PRE), (const float*)(ws + OFF_SSY)};
        pg8::gemm_phase<EpiOutProj, SplitKOrder, true, true>(lds, g, so, e);
    }
    GRID_SYNC();
    phase_ln_mid(P, lane, gw, NGW);
    GRID_SYNC();
    {
        pg8::Gemm g{(const bf16*)(ws + OFF_HB), (const bf16*)(ws + OFF_WQP), S, D, D, D}; pg8::StaticOrder so; so.init(S, D, G, bid);
        EpiPlain e{(bf16*)(ws + OFF_Z), D};
        pg8::gemm_phase<EpiPlain, pg8::StaticOrder, true, true>(lds, g, so, e);
    }
    GRID_SYNC();
    phase_scores(P, lane, gw, NGW);
    GRID_SYNC();
    phase_topk(P, tid, bid, G);
    GRID_SYNC();
    phase_experts(P, lane, gw, NGW);
}

extern "C" void kernel_launch(void* const* d_in, const int* in_sizes, int n_in, void* d_out, int out_size, void* d_ws, size_t ws_size, hipStream_t stream) {
    static int grid_blocks = 0;
    if (grid_blocks == 0) {
        if (n_in != 27 || ws_size < WS_NEED) { fprintf(stderr, "kernel_launch: unexpected n_in %d or ws_size %zu (need %zu)\n", n_in, ws_size, (size_t)WS_NEED); grid_blocks = -1; return; }
        int dev = 0, cus = 0, per_cu = 0;
        (void)hipGetDevice(&dev);
        (void)hipDeviceGetAttribute(&cus, hipDeviceAttributeMultiprocessorCount, dev);
        (void)hipFuncSetAttribute((const void*)hymba_fwd, hipFuncAttributeMaxDynamicSharedMemorySize, LDS_BYTES);
        if (hipOccupancyMaxActiveBlocksPerMultiprocessor(&per_cu, (const void*)hymba_fwd, NTHREADS, LDS_BYTES) != hipSuccess || per_cu < 1) per_cu = 1;
        grid_blocks = cus;
        fprintf(stderr, "kernel_launch: cus %d per_cu %d grid %d\n", cus, per_cu, grid_blocks);
    }
    if (grid_blocks < 0) return;
    Params p{};
    p.x = (const float*)d_in[0]; p.c = (const float*)d_in[1]; p.pos = (const int*)d_in[2]; p.w_ada = (const float*)d_in[3]; p.b_ada = (const float*)d_in[4];
    p.w_in = (const float*)d_in[5]; p.lam_re = (const float*)d_in[6]; p.lam_im = (const float*)d_in[7]; p.log_dt = (const float*)d_in[8];
    p.b_re = (const float*)d_in[9]; p.b_im = (const float*)d_in[10]; p.c_re = (const float*)d_in[11]; p.c_im = (const float*)d_in[12]; p.ssm_d = (const float*)d_in[13];
    p.w_glu = (const float*)d_in[14]; p.b_glu = (const float*)d_in[15]; p.g_attn = (const float*)d_in[16]; p.g_ssm = (const float*)d_in[17]; p.w_out = (const float*)d_in[18];
    p.ln1_g = (const float*)d_in[19]; p.ln1_b = (const float*)d_in[20]; p.w_qp = (const float*)d_in[21]; p.sub_keys = (const float*)d_in[22];
    p.expert_u = (const float*)d_in[23]; p.expert_v = (const float*)d_in[24]; p.ln2_g = (const float*)d_in[25]; p.ln2_b = (const float*)d_in[26];
    p.out = (float*)d_out; p.ws = (unsigned char*)d_ws;
    if (hipMemsetAsync((unsigned char*)d_ws + OFF_BAR, 0, BAR_ZERO_BYTES, stream) != hipSuccess) { fprintf(stderr, "kernel_launch: memset of barrier words failed\n"); return; }
    hipLaunchKernelGGL(hymba_fwd, dim3(grid_blocks), dim3(NTHREADS), LDS_BYTES, stream, p);
    const hipError_t e = hipPeekAtLastError();
    if (e != hipSuccess) fprintf(stderr, "launch failed: %s (grid %d)\n", hipGetErrorString(e), grid_blocks);
}
```
